# Optimizing an MI355X kernel written in HIP

```python
import jax
import jax.numpy as jnp
from jax import lax
import numpy as np

D_MODEL = 1024
BATCH = 8
SEQ = 2048
DEPTH = 1

N_META = 16
GLA_WIDTH = D_MODEL // 2
GLA_HEADS = 4
GLA_DV = GLA_WIDTH // GLA_HEADS
GLA_DK = GLA_DV // 2
GLA_QK = GLA_HEADS * GLA_DK
GATE_RANK = 16
GATE_NORM = 16.0
CHUNK = 64
SUB = 16
CONV_CH = D_MODEL - GLA_WIDTH
CONV_K = 3
D_FF = 4 * D_MODEL
EPS = 1e-6
PROJ_SIZES = (GLA_QK, GLA_QK, GLA_WIDTH, GLA_WIDTH, GATE_RANK, CONV_CH, CONV_CH, CONV_CH)
PROJ_WIDTH = 2 * GLA_QK + 2 * GLA_WIDTH + GATE_RANK + 3 * CONV_CH

kernel_name = "hymba_gla_shortconv_block"


def rms_norm(x, w):
    xf = x.astype(jnp.float32)
    y = xf * lax.rsqrt(jnp.mean(xf * xf, axis=-1, keepdims=True) + EPS)
    return (y * w.astype(jnp.float32)).astype(x.dtype)


def split_cols(p):
    outs = []
    start = 0
    for s in PROJ_SIZES:
        outs.append(p[..., start:start + s])
        start += s
    return outs


def gla_chunked(q, k, v, gk):
    Bsz, Lp, H, dk = q.shape
    dv = v.shape[-1]
    N = Lp // CHUNK
    S = CHUNK // SUB

    def blk(t):
        return t.reshape(Bsz, N, S, SUB, H, t.shape[-1]).transpose(0, 4, 1, 2, 3, 5)

    q, k, v, gk = blk(q), blk(k), blk(v), blk(gk)
    b = jnp.cumsum(gk.reshape(Bsz, H, N, CHUNK, dk), axis=3).reshape(Bsz, H, N, S, SUB, dk)

    b_end = b[..., -1, :]
    r = jnp.concatenate([jnp.zeros_like(b_end[:, :, :, :1]), b_end[:, :, :, :-1]], axis=3)
    q_r = q * jnp.exp(b - r[..., None, :])
    lower = jnp.arange(S)[:, None] > jnp.arange(S)[None, :]
    expo = r[:, :, :, :, None, None, :] - b[:, :, :, None, :, :, :]
    expo = jnp.where(lower[:, :, None, None], expo, -jnp.inf)
    k_rel = k[:, :, :, None] * jnp.exp(expo)
    a_off = jnp.einsum('bhnsid,bhnstjd->bhnsitj', q_r, k_rel)

    causal = jnp.tril(jnp.ones((SUB, SUB), dtype=bool))
    pair = b[..., :, None, :] - b[..., None, :, :]
    pair = jnp.where(causal[:, :, None], pair, -jnp.inf)
    a_diag = jnp.einsum('bhnsid,bhnsjd,bhnsijd->bhnsij', q, k, jnp.exp(pair))
    eye = jnp.eye(S, dtype=a_off.dtype)
    a = a_off + a_diag[..., None, :] * eye[:, None, :, None]
    a = a.reshape(Bsz, H, N, CHUNK, CHUNK)

    qc = q.reshape(Bsz, H, N, CHUNK, dk)
    kc = k.reshape(Bsz, H, N, CHUNK, dk)
    vc = v.reshape(Bsz, H, N, CHUNK, dv)
    bc = b.reshape(Bsz, H, N, CHUNK, dk)
    o_intra = jnp.einsum('bhnij,bhnjv->bhniv', a, vc)

    b_last = bc[..., -1, :]
    kv = jnp.einsum('bhncd,bhncv->bhndv', kc * jnp.exp(b_last[..., None, :] - bc), vc)

    def step(h, inp):
        decay, kv_n = inp
        return h * decay[..., None] + kv_n, h

    h0 = jnp.zeros((Bsz, H, dk, dv), dtype=q.dtype)
    _, h_prev = lax.scan(step, h0, (jnp.moveaxis(jnp.exp(b_last), 2, 0), jnp.moveaxis(kv, 2, 0)))
    h_prev = jnp.moveaxis(h_prev, 0, 2)
    o_inter = jnp.einsum('bhncd,bhndv->bhncv', qc * jnp.exp(bc), h_prev)

    o = o_intra + o_inter
    return o.transpose(0, 2, 3, 1, 4).reshape(Bsz, Lp, H, dv)


def gla_branch(q, k, v, g, gr, w_gate_up, b_gate, norm_w):
    Bsz, L, _ = q.shape
    f32 = jnp.float32
    qh = q.astype(f32).reshape(Bsz, L, GLA_HEADS, GLA_DK) * (GLA_DK ** -0.5)
    kh = k.astype(f32).reshape(Bsz, L, GLA_HEADS, GLA_DK)
    vh = v.astype(f32).reshape(Bsz, L, GLA_HEADS, GLA_DV)
    gk = jax.nn.log_sigmoid(gr.astype(f32) @ w_gate_up.astype(f32) + b_gate.astype(f32)) / GATE_NORM
    gk = gk.reshape(Bsz, L, GLA_HEADS, GLA_DK)
    front = (-N_META) % CHUNK
    back = (-(front + L)) % CHUNK

    def padf(t):
        return jnp.pad(t, ((0, 0), (front, back), (0, 0), (0, 0)))

    o = gla_chunked(padf(qh), padf(kh), padf(vh), padf(gk))[:, front:front + L]
    o = rms_norm(o, norm_w)
    o = o.reshape(Bsz, L, GLA_WIDTH) * jax.nn.silu(g.astype(f32))
    return o.astype(q.dtype)


def short_conv_branch(cb, cc, cx, conv_w):
    u = cc * cx
    y = lax.conv_general_dilated(
        u, conv_w[:, None, :].astype(u.dtype), window_strides=(1,),
        padding=[(CONV_K - 1, 0)], dimension_numbers=('NWC', 'WIO', 'NWC'),
        feature_group_count=CONV_CH)
    return cb * y


def setup_inputs(seed: int = 0) -> dict:
    key = jax.random.key(seed)
    ks = jax.random.split(key, 14)
    n = jax.random.normal
    return {
        'x': n(ks[0], (BATCH, SEQ, D_MODEL), jnp.float32),
        'meta_tokens': n(ks[1], (N_META, D_MODEL), jnp.float32),
        'norm_mix_w': 1.0 + 0.01 * n(ks[2], (DEPTH, D_MODEL), jnp.float32),
        'w_in': n(ks[3], (DEPTH, D_MODEL, PROJ_WIDTH), jnp.float32) * D_MODEL ** -0.5,
        'w_gate_up': n(ks[4], (DEPTH, GATE_RANK, GLA_QK), jnp.float32) * GATE_RANK ** -0.5,
        'b_gate': 0.1 * n(ks[5], (DEPTH, GLA_QK), jnp.float32),
        'gla_norm_w': 1.0 + 0.01 * n(ks[6], (DEPTH, GLA_DV), jnp.float32),
        'conv_w': n(ks[7], (DEPTH, CONV_K, CONV_CH), jnp.float32) * CONV_K ** -0.5,
        'w_out': n(ks[8], (DEPTH, D_MODEL, D_MODEL), jnp.float32) * D_MODEL ** -0.5,
        'norm_mlp_w': 1.0 + 0.01 * n(ks[9], (DEPTH, D_MODEL), jnp.float32),
        'w_up': n(ks[10], (DEPTH, D_MODEL, D_FF), jnp.float32) * D_MODEL ** -0.5,
        'w_down': n(ks[11], (DEPTH, D_FF, D_MODEL), jnp.float32) * D_FF ** -0.5,
        'norm_final_w': 1.0 + 0.01 * n(ks[12], (D_MODEL,), jnp.float32),
    }


def reference(x, meta_tokens, norm_mix_w, w_in, w_gate_up, b_gate, gla_norm_w, conv_w,
              w_out, norm_mlp_w, w_up, w_down, norm_final_w):
    Bsz = x.shape[0]
    meta = jnp.broadcast_to(meta_tokens.astype(x.dtype)[None], (Bsz, N_META, D_MODEL))
    h = jnp.concatenate([meta, x], axis=1)
    for layer in range(DEPTH):
        hn = rms_norm(h, norm_mix_w[layer])
        proj = hn @ w_in[layer]
        q, k, v, g, gr, cb, cc, cx = split_cols(proj)
        y_gla = gla_branch(q, k, v, g, gr, w_gate_up[layer], b_gate[layer], gla_norm_w[layer])
        y_conv = short_conv_branch(cb, cc, cx, conv_w[layer]).astype(h.dtype)
        mixed = jnp.concatenate([y_gla.astype(h.dtype), y_conv], axis=-1) @ w_out[layer]
        h = h + mixed
        hn = rms_norm(h, norm_mlp_w[layer])
        h = h + jnp.square(jax.nn.relu(hn @ w_up[layer])) @ w_down[layer]
    out = rms_norm(h, norm_final_w)
    return out[:, N_META:]
```

```cpp
#include <hip/hip_runtime.h>
#include <hip/hip_cooperative_groups.h>
#include <cstdio>
#include <cstdint>
#include <cmath>
namespace cg = cooperative_groups;
namespace pg8 {
#define PG8_LAS __attribute__((address_space(3)))
typedef unsigned short bf16_t;
typedef short bf16x8 __attribute__((ext_vector_type(8)));
typedef float f32x4 __attribute__((ext_vector_type(4)));
typedef unsigned u32x4 __attribute__((ext_vector_type(4)));
constexpr int BM = 256, BK = 64, HALF = 128, HTB = HALF * BK * 2  , STAGE_BYTES = 8 * HTB, NXCD = 8, WGM = 8;

__host__ __device__ __forceinline__ int lds_byte(int r, int c) { const int st = (r >> 4) * 2 + (c >> 5), rr = r & 15, cc = c & 31, ob = rr * 64 + cc * 2; return st * 1024 + (ob ^ (((ob >> 9) & 1) << 5)); }
__host__ __device__ __forceinline__ void stage_rc(int b, int& R, int& C) { const int st = b / 1024, sb = b % 1024, swz = sb ^ (((sb >> 9) & 1) << 5); R = (st >> 1) * 16 + swz / 64; C = (st & 1) * 32 + (swz % 64) / 2; }
__host__ __device__ __forceinline__ int perm32(int rho) { const int n = rho >> 4, i = rho & 15; return 8 * (i >> 2) + 4 * n + (i & 3); }

struct Unit { int pm, pn; };
struct Gemm { const bf16_t* A; const bf16_t* Bt; int M, N, K; };

struct StaticOrder {
    int nM, nN, nwg, G, c;
    __host__ __device__ void init(int M, int N, int G_, int c_) { nM = M / BM; nN = N / BM; nwg = nM * nN; G = G_; c = c_; }
    __host__ __device__ bool next(int i, Unit& u) const {
        const long L = (long)i * G + c; if (L >= nwg) return false;
        int wgid = (int)L; { const int q = nwg / NXCD, r = nwg % NXCD, xcd = wgid % NXCD, off = wgid / NXCD; wgid = (xcd < r ? xcd * (q + 1) : r * (q + 1) + (xcd - r) * q) + off; }
        const int nig = WGM * nN, gid = wgid / nig, fm = gid * WGM, gsz = (nM - fm) < WGM ? (nM - fm) : WGM;
        u.pm = fm + ((wgid % nig) % gsz); u.pn = (wgid % nig) / gsz; return true;
    }
    __device__ __forceinline__ void a_ready(const Unit&) const {}
    __device__ __forceinline__ void done(const Unit&) const {}
};

__device__ __forceinline__ unsigned cvt_pk_bf16(float lo, float hi) { unsigned r; asm volatile("v_cvt_pk_bf16_f32 %0, %1, %2" : "=v"(r) : "v"(lo), "v"(hi)); return r; }
typedef float f32x2 __attribute__((ext_vector_type(2)));
__device__ __forceinline__ f32x2 gelu_pk(f32x2 v) {
    const f32x2 av = __builtin_elementwise_abs(v), d = av * 0.2316418882f + 1.0f;
    f32x2 t; t.x = __builtin_amdgcn_rcpf(d.x); t.y = __builtin_amdgcn_rcpf(d.y);
    f32x2 q = t * 0.5307027145f + (-0.7265760135f); q = q * t + 0.7107068705f; q = q * t + (-0.142248368f); q = q * t + 0.127414796f; q = q * t;
    const f32x2 s = (v * v) * (-0.72134752044f);
    f32x2 e; e.x = __builtin_amdgcn_exp2f(s.x); e.y = __builtin_amdgcn_exp2f(s.y);
    const f32x2 m = v * (q * e), r = v - m;
    f32x2 o; o.x = v.x < 0.f ? m.x : r.x; o.y = v.y < 0.f ? m.y : r.y; return o;
}

template <int ACT  > struct EpiBf16 {
    static constexpr bool PERM = true, AFTER_DRAIN = false; static_assert(ACT == 0 || ACT == 1, "EpiBf16: ACT is 0 (none) or 1 (gelu_pk)");
    bf16_t* O; int ldc; const float* bias; int split_cols; size_t split_stride; float scale0;
    __device__ __forceinline__ void operator()(const f32x4 (&acc)[2][2][4][2], const Unit& u, int wr, int wc, int fr, int fq) const {
        const int row0 = u.pm * BM + wr * 64 + fr; int colt = u.pn * BM; bf16_t* base = O;
        float sc = 1.f; if (split_cols) { const int t = colt / split_cols; base += (size_t)t * split_stride; colt -= t * split_cols; if (t == 0) sc = scale0; }
        const int col0 = colt + wc * 32 + 8 * fq, bcol0 = u.pn * BM + wc * 32 + 8 * fq;
        f32x4 bv[2][2];
#pragma unroll
        for (int bj = 0; bj < 2; ++bj)
#pragma unroll
            for (int n = 0; n < 2; ++n) bv[bj][n] = bias ? *(const f32x4*)(bias + bcol0 + bj * HALF + 4 * n) : (f32x4){0.f, 0.f, 0.f, 0.f};
#pragma unroll
        for (int ai = 0; ai < 2; ++ai)
#pragma unroll
            for (int m = 0; m < 4; ++m) { bf16_t* rowp = base + (size_t)(row0 + ai * HALF + m * 16) * ldc + col0;
#pragma unroll
                for (int bj = 0; bj < 2; ++bj) { f32x4 v0 = acc[ai][bj][m][0] + bv[bj][0], v1 = acc[ai][bj][m][1] + bv[bj][1];
                    if (ACT == 1) { f32x2 a = gelu_pk((f32x2){v0[0], v0[1]}), b = gelu_pk((f32x2){v0[2], v0[3]}), c = gelu_pk((f32x2){v1[0], v1[1]}), d = gelu_pk((f32x2){v1[2], v1[3]});
                        v0 = (f32x4){a.x, a.y, b.x, b.y}; v1 = (f32x4){c.x, c.y, d.x, d.y}; }
                    v0 = v0 * sc; v1 = v1 * sc; u32x4 w; w.x = cvt_pk_bf16(v0[0], v0[1]); w.y = cvt_pk_bf16(v0[2], v0[3]); w.z = cvt_pk_bf16(v1[0], v1[1]); w.w = cvt_pk_bf16(v1[2], v1[3]);
                    *(u32x4*)(rowp + bj * HALF) = w; } }
    }
};

template <class Epi, class Sched, bool ALIGN_EPI = false, bool SP2 = false>
__device__ __forceinline__ void gemm_phase(PG8_LAS unsigned char* lds, const Gemm g, const Sched& S, const Epi& E) {
    const int tid = threadIdx.x, wid = __builtin_amdgcn_readfirstlane(tid >> 6), lane = tid & 63, wr = wid >> 2, wc = wid & 3, fr = lane & 15, fq = lane >> 4;
    const int K = g.K, nt = K / BK;
    unsigned voffA[2], voffB[2];
#pragma unroll
    for (int i = 0; i < 2; ++i) { int R, C; stage_rc(tid * 16 + i * 8192, R, C); const int Rb = Epi::PERM ? ((R & ~31) + perm32(R & 31)) : R;
        voffA[i] = (unsigned)(R * K + C) * 2u; voffB[i] = (unsigned)(Rb * K + C) * 2u; }
    const size_t kstep = (size_t)(BK * 2);
    const size_t hstep = (size_t)HALF * K * 2;
    const size_t tstep = 2 * hstep;
    const unsigned ldsw = (unsigned)wid * 1024u;
    const int aoff = lds_byte(wr * 64 + fr, fq * 8), boff = lds_byte(wc * 32 + fr, fq * 8);
#define PG8_SA(b, h) (((b) * 2 + (h)) * HTB)
#define PG8_SB(b, h) ((4 + (b) * 2 + (h)) * HTB)
#define PG8_STAGE(bufoff, gbase, voff) do { _Pragma("unroll") for (int _i = 0; _i < 2; ++_i) \
        __builtin_amdgcn_global_load_lds((const unsigned*)((const char*)(gbase) + (voff)[_i]), (PG8_LAS unsigned*)(lds + (bufoff) + ldsw + _i * 8192), 16, 0, 0); } while (0)
#define PG8_LDA(dst, b, h) do { _Pragma("unroll") for (int m = 0; m < 4; ++m) _Pragma("unroll") for (int k = 0; k < 2; ++k) dst[m][k] = *(const PG8_LAS bf16x8*)(lds + PG8_SA(b, h) + aoff + m * 2048 + k * 1024); } while (0)
#define PG8_LDB(dst, b, h) do { _Pragma("unroll") for (int n = 0; n < 2; ++n) _Pragma("unroll") for (int k = 0; k < 2; ++k) dst[n][k] = *(const PG8_LAS bf16x8*)(lds + PG8_SB(b, h) + boff + n * 2048 + k * 1024); } while (0)
#define PG8_MMA(ai, bj, At, Bt) do { __builtin_amdgcn_s_setprio(1); _Pragma("unroll") for (int m = 0; m < 4; ++m) _Pragma("unroll") for (int n = 0; n < 2; ++n) _Pragma("unroll") for (int k = 0; k < 2; ++k) \
        acc[ai][bj][m][n] = __builtin_amdgcn_mfma_f32_16x16x32_bf16(Bt[n][k], At[m][k], acc[ai][bj][m][n], 0, 0, 0); __builtin_amdgcn_s_setprio(0); } while (0)
#define PG8_WAIT_V(n) asm volatile("s_waitcnt vmcnt(" #n ")" ::: "memory")
#define PG8_WAIT_L(n) asm volatile("s_waitcnt lgkmcnt(" #n ")" ::: "memory")
#define PG8_BAR __builtin_amdgcn_s_barrier()
#define PG8_SCHED __builtin_amdgcn_sched_barrier(0)
    Unit cur, nxt; int ui = 0;
    if (!S.next(0, cur)) return;
    f32x4 acc[2][2][4][2];
#pragma unroll
    for (int a = 0; a < 2; ++a)
#pragma unroll
        for (int b = 0; b < 2; ++b)
#pragma unroll
            for (int m = 0; m < 4; ++m)
#pragma unroll
                for (int n = 0; n < 2; ++n) acc[a][b][m][n] = (f32x4){0.f, 0.f, 0.f, 0.f};
    bf16x8 At[4][2], B0[2][2], B1[2][2];
    const char* cA = (const char*)g.A + (size_t)cur.pm * tstep; const char* cB = (const char*)g.Bt + (size_t)cur.pn * tstep;
    S.a_ready(cur);
    if constexpr (SP2) {
        PG8_STAGE(PG8_SB(0, 0), cB, voffB); PG8_STAGE(PG8_SB(0, 1), cB + hstep, voffB); PG8_STAGE(PG8_SA(0, 0), cA, voffA); PG8_STAGE(PG8_SA(0, 1), cA + hstep, voffA);
        if (wr == 1) PG8_BAR;
        PG8_WAIT_V(2); PG8_BAR;
        PG8_STAGE(PG8_SB(1, 0), cB + kstep, voffB); PG8_STAGE(PG8_SA(1, 0), cA + kstep, voffA); PG8_STAGE(PG8_SB(1, 1), cB + hstep + kstep, voffB);
        PG8_WAIT_V(6); PG8_BAR;
    } else {
        PG8_STAGE(PG8_SB(0, 0), cB, voffB); PG8_STAGE(PG8_SA(0, 0), cA, voffA); PG8_STAGE(PG8_SB(0, 1), cB + hstep, voffB); PG8_STAGE(PG8_SA(0, 1), cA + hstep, voffA);
        if (wr == 1) PG8_BAR;
        PG8_WAIT_V(4); PG8_BAR;
        PG8_STAGE(PG8_SB(1, 0), cB + kstep, voffB); PG8_STAGE(PG8_SA(1, 0), cA + kstep, voffA); PG8_STAGE(PG8_SB(1, 1), cB + hstep + kstep, voffB);
        PG8_WAIT_V(6); PG8_BAR;
    }
    for (;;) {
        const bool has_next = S.next(ui + 1, nxt);
        const char* nA = has_next ? (const char*)g.A + (size_t)nxt.pm * tstep : cA; const char* nB = has_next ? (const char*)g.Bt + (size_t)nxt.pn * tstep : cB;
        for (int t = 0; t < nt; t += 2) {
            const bool last = (t == nt - 2);
            const char* a1 = cA + (size_t)(t + 1) * kstep;
            const char* a2 = last ? nA : cA + (size_t)(t + 2) * kstep; const char* b2 = last ? nB : cB + (size_t)(t + 2) * kstep;
            const char* a3 = a2 + kstep; const char* b3 = b2 + kstep;
            if (last && has_next) S.a_ready(nxt);
            if constexpr (SP2) {
            PG8_LDB(B0, 0, 0); PG8_LDB(B1, 0, 1); PG8_SCHED; PG8_LDA(At, 0, 0); PG8_STAGE(PG8_SA(1, 1), a1 + hstep, voffA);
            PG8_WAIT_V(8); PG8_WAIT_L(0); PG8_BAR; PG8_MMA(0, 0, At, B0); PG8_MMA(0, 1, At, B1); PG8_BAR; PG8_SCHED;
            PG8_LDA(At, 0, 1); PG8_STAGE(PG8_SB(0, 0), b2, voffB); PG8_STAGE(PG8_SB(0, 1), b2 + hstep, voffB); PG8_STAGE(PG8_SA(0, 0), a2, voffA);
            PG8_WAIT_V(8); PG8_WAIT_L(0); PG8_BAR; PG8_MMA(1, 0, At, B0); PG8_MMA(1, 1, At, B1); PG8_BAR; PG8_SCHED;
            PG8_LDB(B0, 1, 0); PG8_LDB(B1, 1, 1); PG8_SCHED; PG8_LDA(At, 1, 0); PG8_STAGE(PG8_SA(0, 1), a2 + hstep, voffA);
            PG8_WAIT_V(8); PG8_WAIT_L(0); PG8_BAR; PG8_MMA(0, 0, At, B0); PG8_MMA(0, 1, At, B1); PG8_BAR; PG8_SCHED;
            PG8_LDA(At, 1, 1); PG8_STAGE(PG8_SB(1, 0), b3, voffB); PG8_STAGE(PG8_SB(1, 1), b3 + hstep, voffB); PG8_STAGE(PG8_SA(1, 0), a3, voffA);
            PG8_WAIT_V(8); PG8_WAIT_L(0); PG8_BAR; PG8_MMA(1, 0, At, B0); PG8_MMA(1, 1, At, B1); PG8_BAR; PG8_SCHED;
            } else {
            PG8_LDB(B0, 0, 0); PG8_SCHED; PG8_LDA(At, 0, 0); PG8_STAGE(PG8_SA(1, 1), a1 + hstep, voffA);
            PG8_WAIT_L(8); PG8_BAR; PG8_WAIT_L(0); PG8_MMA(0, 0, At, B0); PG8_BAR; PG8_SCHED;
            PG8_LDB(B1, 0, 1); PG8_STAGE(PG8_SB(0, 0), b2, voffB);
            PG8_BAR; PG8_WAIT_L(0); PG8_MMA(0, 1, At, B1); PG8_BAR;
            PG8_LDA(At, 0, 1); PG8_STAGE(PG8_SA(0, 0), a2, voffA);
            PG8_BAR; PG8_WAIT_L(0); PG8_MMA(1, 0, At, B0); PG8_BAR; PG8_SCHED;
            PG8_STAGE(PG8_SB(0, 1), b2 + hstep, voffB);
            PG8_WAIT_V(6); PG8_BAR; PG8_MMA(1, 1, At, B1); PG8_BAR;
            PG8_LDB(B0, 1, 0); PG8_SCHED; PG8_LDA(At, 1, 0); PG8_STAGE(PG8_SA(0, 1), a2 + hstep, voffA);
            PG8_WAIT_L(8); PG8_BAR; PG8_WAIT_L(0); PG8_MMA(0, 0, At, B0); PG8_BAR; PG8_SCHED;
            PG8_LDB(B1, 1, 1); PG8_STAGE(PG8_SB(1, 0), b3, voffB);
            PG8_BAR; PG8_WAIT_L(0); PG8_MMA(0, 1, At, B1); PG8_BAR;
            PG8_LDA(At, 1, 1); PG8_STAGE(PG8_SA(1, 0), a3, voffA);
            PG8_BAR; PG8_WAIT_L(0); PG8_MMA(1, 0, At, B0); PG8_BAR; PG8_SCHED;
            PG8_STAGE(PG8_SB(1, 1), b3 + hstep, voffB);
            PG8_WAIT_V(6); PG8_BAR; PG8_MMA(1, 1, At, B1); PG8_BAR;
            }
        }
        if constexpr (ALIGN_EPI) { if (wr == 0) PG8_BAR; }
        if constexpr (!Epi::AFTER_DRAIN) { E(acc, cur, wr, wc, fr, fq); S.done(cur); }
        if (!has_next) break;
#pragma unroll
        for (int a = 0; a < 2; ++a)
#pragma unroll
            for (int b = 0; b < 2; ++b)
#pragma unroll
                for (int m = 0; m < 4; ++m)
#pragma unroll
                    for (int n = 0; n < 2; ++n) acc[a][b][m][n] = (f32x4){0.f, 0.f, 0.f, 0.f};
        cur = nxt; cA = nA; cB = nB; ++ui;
        if constexpr (ALIGN_EPI) { if (wr == 1) PG8_BAR; }
    }
    PG8_WAIT_V(0);
    if constexpr (!ALIGN_EPI) { if (wr == 0) PG8_BAR; }
    PG8_BAR;
    if constexpr (Epi::AFTER_DRAIN) { E.fused(acc, cur, wr, wc, fr, fq, lds, wid, lane); S.done(cur); }
#undef PG8_SA
#undef PG8_SB
#undef PG8_STAGE
#undef PG8_LDA
#undef PG8_LDB
#undef PG8_MMA
#undef PG8_WAIT_V
#undef PG8_WAIT_L
#undef PG8_BAR
#undef PG8_SCHED
}
}

#ifndef PG8_SP2
#define PG8_SP2 true
#endif
#ifndef PG8_ALIGN
#define PG8_ALIGN true
#endif
#ifndef SKIPMASK
#define SKIPMASK 0
#endif
#ifndef ONE_LAUNCH
#define ONE_LAUNCH 1
#endif
constexpr int NB = 8, SEQ = 2048, D = 1024, FF = 4096, M = NB * SEQ;
constexpr int NMETA = 16, MR = M + NMETA;
constexpr int PW = 3088, NP = 3072;
constexpr int C_Q = 0, C_K = 256, C_V = 512, C_G = 1024, C_CB = 1536, C_CC = 2048, C_CX = 2560;
constexpr int SRC_GR = 1536;
constexpr float EPS = 1e-6f;
constexpr size_t MiB = 1u << 20;
constexpr size_t WS_SS1 = 0, WS_SS2 = 256 * 1024;
constexpr size_t WS_WIN = 1 * MiB, WS_WOUT = 7 * MiB, WS_WUP = 9 * MiB, WS_WDN = 17 * MiB;
constexpr size_t WS_GR = 25 * MiB;
constexpr size_t WS_AGG = 27 * MiB, WS_DG = 35 * MiB;
constexpr size_t WS_XN = 36 * MiB;
constexpr size_t WS_PROJ = 68 * MiB;
constexpr size_t WS_MIX = 166 * MiB;
constexpr size_t WS_HB = 68 * MiB;
constexpr int LDS_BYTES = 147456;
constexpr int NWAVES = 8, NTHR = 512;

#define LAS __attribute__((address_space(3)))
typedef unsigned short bf16;
typedef unsigned v4u __attribute__((ext_vector_type(4)));
typedef unsigned v2u __attribute__((ext_vector_type(2)));
typedef float f32x4 __attribute__((ext_vector_type(4)));
#define LDS_WAIT() asm volatile("s_waitcnt lgkmcnt(0)" ::: "memory")
__device__ __forceinline__ unsigned f2bf(float f) { unsigned u = __builtin_bit_cast(unsigned, f); return (u + 0x7fffu + ((u >> 16) & 1u)) >> 16; }
__device__ __forceinline__ unsigned pk2(float lo, float hi) { return f2bf(lo) | (f2bf(hi) << 16); }
__device__ __forceinline__ float bflo(unsigned u) { return __builtin_bit_cast(float, u << 16); }
__device__ __forceinline__ float bfhi(unsigned u) { return __builtin_bit_cast(float, u & 0xffff0000u); }
__device__ __forceinline__ void unpack8(v4u p, float (&o)[8]) { o[0] = bflo(p.x); o[1] = bfhi(p.x); o[2] = bflo(p.y); o[3] = bfhi(p.y); o[4] = bflo(p.z); o[5] = bfhi(p.z); o[6] = bflo(p.w); o[7] = bfhi(p.w); }
__device__ __forceinline__ float wave_sum(float v) {
#pragma unroll
    for (int o = 1; o < 64; o <<= 1) v += __shfl_xor(v, o);
    return v;
}

template <bool WB> struct EpiRes {
    static constexpr bool PERM = false, AFTER_DRAIN = true;
    const float* base; float* out; pg8::bf16_t* hb; float* ss;
    __device__ __forceinline__ void fused(pg8::f32x4 (&acc)[2][2][4][2], const pg8::Unit& u, int wr, int wc, int fr, int fq, LAS unsigned char* lds, int wid, int lane) const {
        LAS float* P = (LAS float*)lds;
        const int col0 = u.pn * 256 + wc * 32 + 4 * fq;
#pragma unroll
        for (int ai = 0; ai < 2; ++ai)
#pragma unroll
            for (int m = 0; m < 4; ++m) {
                const int r = ai * 128 + wr * 64 + m * 16 + fr; const size_t off = (size_t)(u.pm * 256 + r) * D + col0; float s = 0.f;
#pragma unroll
                for (int bj = 0; bj < 2; ++bj)
#pragma unroll
                    for (int n = 0; n < 2; ++n) {
                        const f32x4 bs = *(const f32x4*)(base + off + bj * 128 + n * 16); const f32x4 v = acc[ai][bj][m][n] + bs;
                        *(f32x4*)(out + off + bj * 128 + n * 16) = v; s += (v[0] * v[0] + v[1] * v[1]) + (v[2] * v[2] + v[3] * v[3]);
                        if (WB) { v2u w; w.x = pk2(v[0], v[1]); w.y = pk2(v[2], v[3]); *(v2u*)(hb + off + bj * 128 + n * 16) = w; }
                    }
                s += __shfl_xor(s, 16); s += __shfl_xor(s, 32);
                if (fq == 0) P[r * 4 + wc] = s;
                if (m & 1) asm volatile("" ::: "memory");
            }
        __syncthreads();
        const int tid = wid * 64 + lane;
        if (tid < 256) { const f32x4 p = *(const LAS f32x4*)(P + tid * 4); ss[(size_t)(u.pm * 256 + tid) * 4 + u.pn] = (p[0] + p[1]) + (p[2] + p[3]); }
    }
};
struct EpiUp {
    static constexpr bool PERM = true, AFTER_DRAIN = false;
    pg8::bf16_t* O; int ldc; const float* ss;
    __device__ __forceinline__ void operator()(const pg8::f32x4 (&acc)[2][2][4][2], const pg8::Unit& u, int wr, int wc, int fr, int fq) const {
        const int row0 = u.pm * 256 + wr * 64 + fr, col0 = u.pn * 256 + wc * 32 + 8 * fq;
#pragma unroll
        for (int ai = 0; ai < 2; ++ai)
#pragma unroll
            for (int m = 0; m < 4; ++m) {
                const int row = row0 + ai * 128 + m * 16; const f32x4 s4 = *(const f32x4*)(ss + (size_t)row * 4);
                const float rstd = __builtin_amdgcn_rsqf(((s4[0] + s4[1]) + (s4[2] + s4[3])) * (1.0f / D) + EPS);
                pg8::bf16_t* rowp = O + (size_t)row * ldc + col0;
#pragma unroll
                for (int bj = 0; bj < 2; ++bj) {
                    f32x4 v0 = acc[ai][bj][m][0] * rstd, v1 = acc[ai][bj][m][1] * rstd;
#pragma unroll
                    for (int e = 0; e < 4; ++e) { const float a = fmaxf(v0[e], 0.f), b = fmaxf(v1[e], 0.f); v0[e] = a * a; v1[e] = b * b; }
                    v4u w; w.x = pg8::cvt_pk_bf16(v0[0], v0[1]); w.y = pg8::cvt_pk_bf16(v0[2], v0[3]); w.z = pg8::cvt_pk_bf16(v1[0], v1[1]); w.w = pg8::cvt_pk_bf16(v1[2], v1[3]);
                    *(v4u*)(rowp + bj * 128) = w;
                }
            }
    }
};

struct Args { const float* in[13]; float* out; unsigned char* ws; int ph_lo, ph_hi; };
struct Frame {
    LAS unsigned char* lds; int tid, lane, wave, G, bx;
    const float *x, *meta, *nmix, *win, *wgu, *bgate, *gnw, *convw, *wout, *nmlp, *wup, *wdn, *nfin; float* out;
    bf16 *WinT, *WoutT, *WupT, *WdnT, *XN, *PROJ, *MIX, *HB; float *GR, *AGG, *DG, *SS1, *SS2;
};

__device__ __forceinline__ void p0_transpose_item(const float* W, int ldw, int K, bf16* WT, int n0, int sc0, int k0, const float* kscale, float cscale, LAS float* scr, int lane) {
#pragma unroll 8
    for (int i = 0; i < 32; ++i) { const int kk = 2 * i + (lane >> 5); float s = cscale; if (kscale) s *= kscale[k0 + kk]; scr[kk * 33 + (lane & 31)] = W[(size_t)(k0 + kk) * ldw + sc0 + (lane & 31)] * s; }
    LDS_WAIT(); asm volatile("" ::: "memory");
    const int c = lane & 7;
#pragma unroll
    for (int j = 0; j < 4; ++j) { const int n = (lane >> 3) + 8 * j; const LAS float* s = scr + (8 * c) * 33 + n;
        v4u o; o.x = pk2(s[0 * 33], s[1 * 33]); o.y = pk2(s[2 * 33], s[3 * 33]); o.z = pk2(s[4 * 33], s[5 * 33]); o.w = pk2(s[6 * 33], s[7 * 33]);
        *(v4u*)(WT + (size_t)(n0 + n) * K + k0 + 8 * c) = o; }
    LDS_WAIT(); asm volatile("" ::: "memory");
}
__device__ __forceinline__ void p0_prologue(Frame& F) {
    const int tid = F.tid, lane = F.lane, wave = F.wave;
    if (F.bx < 28) {
        LAS float* xm = (LAS float*)F.lds;
        LAS float* red = xm + 16384;
#pragma unroll
        for (int rr = 0; rr < 2; ++rr) {
            const int r = 2 * wave + rr; const f32x4* xr = (const f32x4*)(F.meta + (size_t)r * D) + lane; const f32x4* nw = (const f32x4*)F.nmix + lane;
            f32x4 v[4]; float s = 0.f;
#pragma unroll
            for (int j = 0; j < 4; ++j) { v[j] = xr[64 * j]; s += (v[j][0] * v[j][0] + v[j][1] * v[j][1]) + (v[j][2] * v[j][2] + v[j][3] * v[j][3]); }
            const float rstd = 1.0f / sqrtf(wave_sum(s) * (1.0f / D) + EPS);
#pragma unroll
            for (int j = 0; j < 4; ++j) { const f32x4 w4 = nw[64 * j];
#pragma unroll
                for (int i = 0; i < 4; ++i) xm[(256 * j + 4 * lane + i) * 16 + r] = v[j][i] * rstd * w4[i]; }
        }
        __syncthreads();
        {
            const int j = F.bx * 64 + lane; const int pc = j < 768 ? 256 + j : 2048 + (j - 768); const int sc = pc < 1536 ? pc : pc + 16;
            float acc[16];
#pragma unroll
            for (int r = 0; r < 16; ++r) acc[r] = 0.f;
            const float* wp = F.win + (size_t)(128 * wave) * PW + sc;
#pragma unroll 4
            for (int k = 0; k < 128; ++k) {
                const float wv = wp[(size_t)k * PW]; const LAS f32x4* xp = (const LAS f32x4*)(xm + (128 * wave + k) * 16);
#pragma unroll
                for (int q = 0; q < 4; ++q) { const f32x4 x4 = xp[q];
#pragma unroll
                    for (int i = 0; i < 4; ++i) acc[4 * q + i] += x4[i] * wv; }
            }
#pragma unroll
            for (int r = 0; r < 16; ++r) red[(wave * 16 + r) * 64 + lane] = acc[r];
        }
        __syncthreads();
#pragma unroll
        for (int i = 0; i < 2; ++i) {
            const int o = tid + 512 * i, r = o >> 6, l = o & 63; float s = 0.f;
#pragma unroll
            for (int w = 0; w < 8; ++w) s += red[(w * 16 + r) * 64 + l];
            const int j = F.bx * 64 + l; const int pc = j < 768 ? 256 + j : 2048 + (j - 768);
            F.PROJ[(size_t)(M + r) * NP + pc] = (bf16)f2bf(s);
        }
        __syncthreads();
    }
    {
        LAS float* scr = (LAS float*)(F.lds + wave * 16384);
        const int gw = F.bx * NWAVES + wave, NGW = F.G * NWAVES;
        constexpr int I_IN = 16 * 96, I_OUT = 16 * 32, I_UP = 16 * 128, I_DN = 64 * 32, NITEMS = I_IN + I_OUT + I_UP + I_DN;
        for (int it = gw; it < NITEMS; it += NGW) {
            int r = it;
            if (r < I_IN) { const int kb = r / 96, nb = r % 96, n0 = 32 * nb; p0_transpose_item(F.win, PW, D, F.WinT, n0, n0 < 1536 ? n0 : n0 + 16, 64 * kb, nullptr, n0 < 256 ? 0.125f : 1.0f, scr, lane); continue; } r -= I_IN;
            if (r < I_OUT) { const int kb = r / 32, nb = r % 32; p0_transpose_item(F.wout, D, D, F.WoutT, 32 * nb, 32 * nb, 64 * kb, nullptr, 1.0f, scr, lane); continue; } r -= I_OUT;
            if (r < I_UP) { const int kb = r / 128, nb = r % 128; p0_transpose_item(F.wup, FF, D, F.WupT, 32 * nb, 32 * nb, 64 * kb, F.nmlp, 1.0f, scr, lane); continue; } r -= I_UP;
            { const int kb = r / 32, nb = r % 32; p0_transpose_item(F.wdn, D, FF, F.WdnT, 32 * nb, 32 * nb, 64 * kb, nullptr, 1.0f, scr, lane); }
        }
    }
    __syncthreads();
    {
        LAS f32x4* T = (LAS f32x4*)F.lds;
#pragma unroll
        for (int i = 0; i < 8; ++i) { const int e = tid + 512 * i, ln = e & 63, c4 = (e >> 6) & 3, kg = e >> 8; const int k = 256 * (kg >> 2) + 4 * ln + (kg & 3);
            T[e] = *(const f32x4*)(F.win + (size_t)k * PW + SRC_GR + 4 * c4); }
        __syncthreads();
        const int gw = F.bx * NWAVES + wave, NGW = F.G * NWAVES;
        const f32x4* nw = (const f32x4*)F.nmix + lane;
        f32x4 nw4[4];
#pragma unroll
        for (int j = 0; j < 4; ++j) nw4[j] = nw[64 * j];
        for (int m = gw; m < MR; m += NGW) {
            asm volatile("" ::: "memory");
            const f32x4* xr = (const f32x4*)(m < M ? F.x + (size_t)m * D : F.meta + (size_t)(m - M) * D) + lane;
            f32x4 v[4]; float s = 0.f;
#pragma unroll
            for (int j = 0; j < 4; ++j) { v[j] = xr[64 * j]; s += (v[j][0] * v[j][0] + v[j][1] * v[j][1]) + (v[j][2] * v[j][2] + v[j][3] * v[j][3]); }
            const float rstd = 1.0f / sqrtf(wave_sum(s) * (1.0f / D) + EPS);
#pragma unroll
            for (int j = 0; j < 4; ++j) v[j] = v[j] * rstd * nw4[j];
            if (m < M) { unsigned long long* o8 = (unsigned long long*)(F.XN + (size_t)m * D) + lane;
#pragma unroll
                for (int j = 0; j < 4; ++j) o8[64 * j] = (unsigned long long)pk2(v[j][0], v[j][1]) | ((unsigned long long)pk2(v[j][2], v[j][3]) << 32); }
            float acc[16];
#pragma unroll
            for (int c = 0; c < 16; ++c) acc[c] = 0.f;
#pragma unroll
            for (int kg = 0; kg < 16; ++kg) { const float xv = v[kg >> 2][kg & 3];
#pragma unroll
                for (int c4 = 0; c4 < 4; ++c4) { const f32x4 w4 = T[(kg * 4 + c4) * 64 + lane];
#pragma unroll
                    for (int i = 0; i < 4; ++i) acc[4 * c4 + i] += xv * w4[i]; } }
            float r8[8], r4[4], r2[2], r1;
#pragma unroll
            for (int i = 0; i < 8; ++i) { const bool up = lane & 32; const float send = up ? acc[i] : acc[i + 8], keep = up ? acc[i + 8] : acc[i]; r8[i] = keep + __shfl_xor(send, 32); }
#pragma unroll
            for (int i = 0; i < 4; ++i) { const bool up = lane & 16; const float send = up ? r8[i] : r8[i + 4], keep = up ? r8[i + 4] : r8[i]; r4[i] = keep + __shfl_xor(send, 16); }
#pragma unroll
            for (int i = 0; i < 2; ++i) { const bool up = lane & 8; const float send = up ? r4[i] : r4[i + 2], keep = up ? r4[i + 2] : r4[i]; r2[i] = keep + __shfl_xor(send, 8); }
            { const bool up = lane & 4; const float send = up ? r2[0] : r2[1], keep = up ? r2[1] : r2[0]; r1 = keep + __shfl_xor(send, 4); }
            r1 += __shfl_xor(r1, 2); r1 += __shfl_xor(r1, 1);
            if ((lane & 3) == 0) F.GR[(size_t)m * 16 + (lane >> 2)] = r1;
        }
    }
    __syncthreads();
}

__device__ __forceinline__ LAS float* opq(LAS float* p) { asm volatile("" : "+v"(p)); return p; }
constexpr int LS = 68;
constexpr int L_QBT = 0, L_KBT = 4352, L_AT = 8704, L_KD = 13056, L_V = 17408, L_H = 25600, L_EBL = 33792, L_WG = 33856, L_BG = 34880;
static_assert((L_BG + 64) * 4 <= LDS_BYTES, "GLA LDS map");

template <bool FULL>
__device__ __forceinline__ void gla_stage_a(LAS float* L, const bf16* PROJ, const float* GR, int hh, bool meta, size_t m0, int tid) {
    asm volatile("" ::: "memory");
    const int w = tid >> 6, t = tid & 63;
    const bool valid = !meta || t >= 48;
    const size_t row = meta ? (size_t)(M + (valid ? t - 48 : 0)) : m0 + t;
    float gr[16];
    { const f32x4* gp = (const f32x4*)(GR + row * 16);
#pragma unroll
        for (int q = 0; q < 4; ++q) { f32x4 g4 = gp[q]; gr[4 * q] = g4[0]; gr[4 * q + 1] = g4[1]; gr[4 * q + 2] = g4[2]; gr[4 * q + 3] = g4[3]; } }
    float b[8];
    { const f32x4 z0 = *(const LAS f32x4*)(L + L_BG + 8 * w), z1 = *(const LAS f32x4*)(L + L_BG + 8 * w + 4);
      b[0] = z0[0]; b[1] = z0[1]; b[2] = z0[2]; b[3] = z0[3]; b[4] = z1[0]; b[5] = z1[1]; b[6] = z1[2]; b[7] = z1[3]; }
#pragma unroll
    for (int r = 0; r < 16; ++r) { const f32x4 w0 = *(const LAS f32x4*)(L + L_WG + r * 64 + 8 * w), w1 = *(const LAS f32x4*)(L + L_WG + r * 64 + 8 * w + 4);
#pragma unroll
        for (int i = 0; i < 4; ++i) { b[i] += gr[r] * w0[i]; b[4 + i] += gr[r] * w1[i]; }
        if ((r & 3) == 3) asm volatile("" ::: "memory"); }
#pragma unroll
    for (int i = 0; i < 8; ++i) { const float z = b[i]; const float ls = fminf(z, 0.f) - log1pf(__expf(-fabsf(z))); b[i] = valid ? ls * (1.0f / 16.0f) : 0.f; }
#pragma unroll
    for (int off = 1; off < 64; off <<= 1) {
#pragma unroll
        for (int i = 0; i < 8; ++i) { const float tmp = __shfl_up(b[i], off); if (t >= off) b[i] += tmp; } }
    v4u k8 = (v4u){0u, 0u, 0u, 0u}, q8 = (v4u){0u, 0u, 0u, 0u};
    if (valid) { k8 = *(const v4u*)(PROJ + row * NP + C_K + hh * 64 + 8 * w); if (FULL) q8 = *(const v4u*)(PROJ + row * NP + C_Q + hh * 64 + 8 * w); }
    float kf[8], qf[8]; unpack8(k8, kf); unpack8(q8, qf);
    float kdv[8];
#pragma unroll
    for (int i = 0; i < 8; ++i) { const int d = 8 * w + i; const float bl = __shfl(b[i], 63);
        kdv[i] = kf[i] * __expf(bl - b[i]);
        if (FULL) { L[L_QBT + d * LS + t] = qf[i] * __expf(b[i]); L[L_KBT + d * LS + t] = kf[i] * __expf(-b[i]); }
        if (t == 0) L[L_EBL + d] = __expf(bl); }
    *(LAS f32x4*)(L + L_KD + t * LS + 8 * w) = (f32x4){kdv[0], kdv[1], kdv[2], kdv[3]};
    *(LAS f32x4*)(L + L_KD + t * LS + 8 * w + 4) = (f32x4){kdv[4], kdv[5], kdv[6], kdv[7]};
#pragma unroll
    for (int i = 0; i < 2; ++i) { const int e = tid + 512 * i, tok = e >> 4, piece = e & 15; const bool vv = !meta || tok >= 48;
        const size_t rv = meta ? (size_t)(M + (vv ? tok - 48 : 0)) : m0 + tok;
        v4u p = (v4u){0u, 0u, 0u, 0u}; if (vv) p = *(const v4u*)(PROJ + rv * NP + C_V + hh * 128 + 8 * piece);
        float f[8]; unpack8(p, f);
        *(LAS f32x4*)(L + L_V + tok * 128 + 8 * piece) = (f32x4){f[0], f[1], f[2], f[3]};
        *(LAS f32x4*)(L + L_V + tok * 128 + 8 * piece + 4) = (f32x4){f[4], f[5], f[6], f[7]}; }
}
__device__ __forceinline__ void gla_delta(const LAS float* L, int c, int ig, float (&dl)[16]) {
#pragma unroll
    for (int dd = 0; dd < 16; ++dd) dl[dd] = 0.f;
#pragma unroll 4
    for (int t = 0; t < 64; ++t) { const float vv = L[L_V + t * 128 + c]; const LAS f32x4* kp = (const LAS f32x4*)(L + L_KD + t * LS + 16 * ig);
#pragma unroll
        for (int q = 0; q < 4; ++q) { const f32x4 k4 = kp[q];
#pragma unroll
            for (int i = 0; i < 4; ++i) dl[4 * q + i] += k4[i] * vv; } }
}
__device__ __forceinline__ void gla_state_chunk(LAS float* L, const Frame& F, int hh, bool meta, size_t m0, float (&hreg)[16], float& dprod) {
    const int tid = F.tid, c = tid & 127, ig = tid >> 7;
    gla_stage_a<false>(L, F.PROJ, F.GR, hh, meta, m0, tid);
    __syncthreads();
    float dl[16]; gla_delta(L, c, ig, dl);
    const LAS float* ebp = opq(L + L_EBL + 16 * ig);
#pragma unroll
    for (int dd = 0; dd < 16; ++dd) hreg[dd] = ebp[dd] * hreg[dd] + dl[dd];
    if (tid < 64) dprod *= ebp[tid - 16 * ig];
    __syncthreads();
}
__device__ __forceinline__ void gla_load_gate(LAS float* L, const Frame& F, int hh) {
    for (int e = F.tid; e < 1024; e += NTHR) L[L_WG + e] = F.wgu[(e >> 6) * 256 + hh * 64 + (e & 63)];
    if (F.tid < 64) L[L_BG + F.tid] = F.bgate[hh * 64 + F.tid];
}
__device__ __forceinline__ void p2a_phase(Frame& F) {
    LAS float* L = (LAS float*)F.lds;
    for (int u = F.bx; u < 256; u += F.G) {
        const int g = u & 7, hh = (u >> 3) & 3, b = u >> 5;
        if (g == 7) continue;
        gla_load_gate(L, F, hh);
        __syncthreads();
        float hreg[16]; float dprod = 1.f;
#pragma unroll
        for (int dd = 0; dd < 16; ++dd) hreg[dd] = 0.f;
        if (g == 0) gla_state_chunk(L, F, hh, true, 0, hreg, dprod);
        for (int cc = 0; cc < 4; ++cc) gla_state_chunk(L, F, hh, false, (size_t)b * SEQ + (size_t)(4 * g + cc) * 64, hreg, dprod);
        f32x4* ap = (f32x4*)(F.AGG + ((size_t)u * NTHR + F.tid) * 16);
#pragma unroll
        for (int q = 0; q < 4; ++q) ap[q] = (f32x4){hreg[4 * q], hreg[4 * q + 1], hreg[4 * q + 2], hreg[4 * q + 3]};
        if (F.tid < 64) F.DG[u * 64 + F.tid] = dprod;
    }
}
__device__ __forceinline__ void conv_loadu(const bf16* PROJ, size_t row, int ch, float (&u)[8]) {
    const v4u a = *(const v4u*)(PROJ + row * NP + C_CC + ch), b = *(const v4u*)(PROJ + row * NP + C_CX + ch);
    float fa[8], fb[8]; unpack8(a, fa); unpack8(b, fb);
#pragma unroll
    for (int i = 0; i < 8; ++i) u[i] = fa[i] * fb[i];
}
__device__ __forceinline__ void p2b_phase(Frame& F) {
    LAS float* L = (LAS float*)F.lds;
    const int tid = F.tid, c = tid & 127, ig = tid >> 7;
    for (int u = F.bx; u < 256; u += F.G) {
        const int g = u & 7, hh = (u >> 3) & 3, b = u >> 5;
        gla_load_gate(L, F, hh);
        __syncthreads();
        float hreg[16]; float dprod = 1.f;
        if (g == 0) {
#pragma unroll
            for (int dd = 0; dd < 16; ++dd) hreg[dd] = 0.f;
            gla_state_chunk(L, F, hh, true, 0, hreg, dprod);
        } else {
            const int u0 = u & ~7;
            { const f32x4* ap = (const f32x4*)(F.AGG + ((size_t)u0 * NTHR + tid) * 16);
#pragma unroll
                for (int q = 0; q < 4; ++q) { const f32x4 a4 = ap[q]; hreg[4 * q] = a4[0]; hreg[4 * q + 1] = a4[1]; hreg[4 * q + 2] = a4[2]; hreg[4 * q + 3] = a4[3]; } }
            for (int gp = 1; gp < g; ++gp) {
                const f32x4* ap = (const f32x4*)(F.AGG + ((size_t)(u0 + gp) * NTHR + tid) * 16); const f32x4* dp = (const f32x4*)(F.DG + (size_t)(u0 + gp) * 64 + 16 * ig);
#pragma unroll
                for (int q = 0; q < 4; ++q) { const f32x4 a4 = ap[q], d4 = dp[q];
#pragma unroll
                    for (int i = 0; i < 4; ++i) hreg[4 * q + i] = d4[i] * hreg[4 * q + i] + a4[i]; }
            }
        }
        LAS float* hp = opq(L + L_H + (16 * ig) * 128 + c); LAS float* obp = opq(L + L_KBT + (16 * ig) * 132 + c); const LAS float* ebp = opq(L + L_EBL + 16 * ig);
#pragma unroll
        for (int dd = 0; dd < 16; ++dd) hp[dd * 128] = hreg[dd];
        __syncthreads();
        for (int cc = 0; cc < 4; ++cc) {
            asm volatile("" ::: "memory");
            const size_t m0 = (size_t)b * SEQ + (size_t)(4 * g + cc) * 64;
            gla_stage_a<true>(L, F.PROJ, F.GR, hh, false, m0, tid);
            __syncthreads();
            {
                const int i = tid >> 3, jg = tid & 7; float acc[8];
#pragma unroll
                for (int jj = 0; jj < 8; ++jj) acc[jj] = 0.f;
#pragma unroll 4
                for (int d = 0; d < 64; ++d) { const float qv = L[L_QBT + d * LS + i];
#pragma unroll
                    for (int jj = 0; jj < 8; ++jj) acc[jj] += qv * L[L_KBT + d * LS + jg + 8 * jj]; }
#pragma unroll
                for (int jj = 0; jj < 8; ++jj) { const int j = jg + 8 * jj; L[L_AT + j * LS + i] = (j <= i) ? acc[jj] : 0.f; }
            }
            __syncthreads();
            float o[16];
#pragma unroll
            for (int ii = 0; ii < 16; ++ii) o[ii] = 0.f;
#pragma unroll 4
            for (int j = 0; j < 16 * (ig + 1); ++j) { const float vv = L[L_V + j * 128 + c]; const LAS f32x4* ap = (const LAS f32x4*)(L + L_AT + j * LS + 16 * ig);
#pragma unroll
                for (int q = 0; q < 4; ++q) { const f32x4 a4 = ap[q];
#pragma unroll
                    for (int i = 0; i < 4; ++i) o[4 * q + i] += a4[i] * vv; } }
#pragma unroll 4
            for (int d = 0; d < 64; ++d) { const float hv = L[L_H + d * 128 + c]; const LAS f32x4* qp = (const LAS f32x4*)(L + L_QBT + d * LS + 16 * ig);
#pragma unroll
                for (int q = 0; q < 4; ++q) { const f32x4 q4 = qp[q];
#pragma unroll
                    for (int i = 0; i < 4; ++i) o[4 * q + i] += q4[i] * hv; } }
            float dl[16]; gla_delta(L, c, ig, dl);
            __syncthreads();
#pragma unroll
            for (int dd = 0; dd < 16; ++dd) { hreg[dd] = ebp[dd] * hreg[dd] + dl[dd]; hp[dd * 128] = hreg[dd]; }
#pragma unroll
            for (int ii = 0; ii < 16; ++ii) obp[ii * 132] = o[ii];
            __syncthreads();
            {
                asm volatile("" ::: "memory");
                const int i = tid >> 3, part = tid & 7; const size_t row = m0 + i;
                const LAS f32x4* op = (const LAS f32x4*)(L + L_KBT + i * 132 + 16 * part);
                f32x4 ov[4]; float s = 0.f;
#pragma unroll
                for (int q = 0; q < 4; ++q) { ov[q] = op[q]; s += (ov[q][0] * ov[q][0] + ov[q][1] * ov[q][1]) + (ov[q][2] * ov[q][2] + ov[q][3] * ov[q][3]); }
                s += __shfl_xor(s, 1); s += __shfl_xor(s, 2); s += __shfl_xor(s, 4);
                const float rstd = 1.0f / sqrtf(s * (1.0f / 128.0f) + EPS);
                const v4u g0 = *(const v4u*)(F.PROJ + row * NP + C_G + hh * 128 + 16 * part), g1 = *(const v4u*)(F.PROJ + row * NP + C_G + hh * 128 + 16 * part + 8);
                float gf[16]; { float t0[8], t1[8]; unpack8(g0, t0); unpack8(g1, t1);
#pragma unroll
                    for (int e = 0; e < 8; ++e) { gf[e] = t0[e]; gf[8 + e] = t1[e]; } }
                float y[16];
#pragma unroll
                for (int q = 0; q < 4; ++q) { const f32x4 w4 = *(const f32x4*)(F.gnw + 16 * part + 4 * q);
#pragma unroll
                    for (int e = 0; e < 4; ++e) { const float gg = gf[4 * q + e]; y[4 * q + e] = ov[q][e] * rstd * w4[e] * (gg / (1.0f + __expf(-gg))); } }
                v4u w0, w1; w0.x = pk2(y[0], y[1]); w0.y = pk2(y[2], y[3]); w0.z = pk2(y[4], y[5]); w0.w = pk2(y[6], y[7]);
                w1.x = pk2(y[8], y[9]); w1.y = pk2(y[10], y[11]); w1.z = pk2(y[12], y[13]); w1.w = pk2(y[14], y[15]);
                *(v4u*)(F.MIX + row * D + hh * 128 + 16 * part) = w0; *(v4u*)(F.MIX + row * D + hh * 128 + 16 * part + 8) = w1;
            }
            __syncthreads();
        }
        {
            const int cgp = tid & 63, rs = tid >> 6, ch = 8 * cgp; const size_t ms = (size_t)64 * u + rs * 8;
            float w0[8], w1[8], w2[8];
#pragma unroll
            for (int q = 0; q < 2; ++q) { const f32x4 a = *(const f32x4*)(F.convw + ch + 4 * q), bb = *(const f32x4*)(F.convw + 512 + ch + 4 * q), cc4 = *(const f32x4*)(F.convw + 1024 + ch + 4 * q);
#pragma unroll
                for (int e = 0; e < 4; ++e) { w0[4 * q + e] = a[e]; w1[4 * q + e] = bb[e]; w2[4 * q + e] = cc4[e]; } }
            const bool first = (ms % SEQ) == 0;
            float u2[8], u1[8], u0[8];
            conv_loadu(F.PROJ, first ? (size_t)(M + 14) : ms - 2, ch, u2);
            conv_loadu(F.PROJ, first ? (size_t)(M + 15) : ms - 1, ch, u1);
#pragma unroll 2
            for (int r = 0; r < 8; ++r) { const size_t row = ms + r; conv_loadu(F.PROJ, row, ch, u0);
                const v4u cb8 = *(const v4u*)(F.PROJ + row * NP + C_CB + ch); float cb[8], y[8]; unpack8(cb8, cb);
#pragma unroll
                for (int e = 0; e < 8; ++e) { y[e] = cb[e] * (w0[e] * u2[e] + w1[e] * u1[e] + w2[e] * u0[e]); u2[e] = u1[e]; u1[e] = u0[e]; }
                v4u wv; wv.x = pk2(y[0], y[1]); wv.y = pk2(y[2], y[3]); wv.z = pk2(y[4], y[5]); wv.w = pk2(y[6], y[7]);
                *(v4u*)(F.MIX + row * D + 512 + ch) = wv; }
        }
    }
}

__global__ void __launch_bounds__(NTHR, 2) fwd(Args args) {
    extern __shared__ __attribute__((aligned(16))) unsigned char lds[];
    cg::grid_group grid = cg::this_grid();
    Frame F;
    F.lds = (LAS unsigned char*)lds; F.tid = threadIdx.x; F.lane = F.tid & 63; F.wave = __builtin_amdgcn_readfirstlane(F.tid >> 6); F.G = gridDim.x; F.bx = blockIdx.x;
    F.x = args.in[0]; F.meta = args.in[1]; F.nmix = args.in[2]; F.win = args.in[3]; F.wgu = args.in[4]; F.bgate = args.in[5]; F.gnw = args.in[6]; F.convw = args.in[7];
    F.wout = args.in[8]; F.nmlp = args.in[9]; F.wup = args.in[10]; F.wdn = args.in[11]; F.nfin = args.in[12]; F.out = args.out;
    unsigned char* ws = args.ws;
    F.WinT = (bf16*)(ws + WS_WIN); F.WoutT = (bf16*)(ws + WS_WOUT); F.WupT = (bf16*)(ws + WS_WUP); F.WdnT = (bf16*)(ws + WS_WDN);
    F.XN = (bf16*)(ws + WS_XN); F.PROJ = (bf16*)(ws + WS_PROJ); F.MIX = (bf16*)(ws + WS_MIX); F.HB = (bf16*)(ws + WS_HB);
    F.GR = (float*)(ws + WS_GR); F.AGG = (float*)(ws + WS_AGG); F.DG = (float*)(ws + WS_DG); F.SS1 = (float*)(ws + WS_SS1); F.SS2 = (float*)(ws + WS_SS2);
    const int lo = args.ph_lo, hi = args.ph_hi;
#define IN(k) (lo <= (k) && (k) < hi)
#define SEAM(k) do { if (IN(k) && IN((k) + 1)) grid.sync(); } while (0)
    if (IN(0) && !(SKIPMASK & 1)) { p0_prologue(F); } SEAM(0);
    if (IN(1) && !(SKIPMASK & 2)) {
        pg8::Gemm g{F.XN, F.WinT, M, NP, D}; pg8::StaticOrder S; S.init(M, NP, F.G, F.bx);
        pg8::EpiBf16<0> E{F.PROJ, NP, nullptr, 0, 0, 1.0f};
        pg8::gemm_phase<pg8::EpiBf16<0>, pg8::StaticOrder, PG8_ALIGN, PG8_SP2>(F.lds, g, S, E);
    } SEAM(1);
    if (IN(2) && !(SKIPMASK & 4)) { p2a_phase(F); } SEAM(2);
    if (IN(3) && !(SKIPMASK & 8)) { p2b_phase(F); } SEAM(3);
    if (IN(4) && !(SKIPMASK & 16)) {
        pg8::Gemm g{F.MIX, F.WoutT, M, D, D}; pg8::StaticOrder S; S.init(M, D, F.G, F.bx);
        EpiRes<true> E{F.x, F.out, F.XN, F.SS1};
        pg8::gemm_phase<EpiRes<true>, pg8::StaticOrder, false, PG8_SP2>(F.lds, g, S, E);
    } SEAM(4);
    if (IN(5) && !(SKIPMASK & 32)) {
        pg8::Gemm g{F.XN, F.WupT, M, FF, D}; pg8::StaticOrder S; S.init(M, FF, F.G, F.bx);
        EpiUp E{F.HB, FF, F.SS1};
        pg8::gemm_phase<EpiUp, pg8::StaticOrder, PG8_ALIGN, PG8_SP2>(F.lds, g, S, E);
    } SEAM(5);
    if (IN(6) && !(SKIPMASK & 64)) {
        pg8::Gemm g{F.HB, F.WdnT, M, D, FF}; pg8::StaticOrder S; S.init(M, D, F.G, F.bx);
        EpiRes<false> E{F.out, F.out, nullptr, F.SS2};
        pg8::gemm_phase<EpiRes<false>, pg8::StaticOrder, false, PG8_SP2>(F.lds, g, S, E);
    } SEAM(6);
    if (IN(7) && !(SKIPMASK & 128)) {
        const int gw = F.bx * NWAVES + F.wave, NGW = F.G * NWAVES; const f32x4* nw = (const f32x4*)F.nfin + F.lane;
        f32x4 nw4[4];
#pragma unroll
        for (int j = 0; j < 4; ++j) nw4[j] = nw[64 * j];
        for (int m = gw; m < M; m += NGW) {
            f32x4* xr = (f32x4*)(F.out + (size_t)m * D) + F.lane; const f32x4 s4 = *(const f32x4*)(F.SS2 + (size_t)m * 4);
            const float rstd = 1.0f / sqrtf(((s4[0] + s4[1]) + (s4[2] + s4[3])) * (1.0f / D) + EPS);
#pragma unroll
            for (int j = 0; j < 4; ++j) { const f32x4 v = xr[64 * j]; xr[64 * j] = v * rstd * nw4[j]; }
        }
    }
#undef IN
#undef SEAM
}

extern "C" void kernel_launch(void* const* d_in, const int* in_sizes, int n_in, void* d_out, int out_size, void* d_ws, size_t ws_size, hipStream_t stream) {
    static int grid = 0;
    if (grid == 0) {
        if (n_in != 13 || out_size != M * D || ws_size < 200 * MiB) { fprintf(stderr, "kernel_launch: unexpected problem shape\n"); grid = -1; return; }
        if (hipFuncSetAttribute((const void*)fwd, hipFuncAttributeMaxDynamicSharedMemorySize, LDS_BYTES) != hipSuccess) { fprintf(stderr, "kernel_launch: hipFuncSetAttribute failed\n"); grid = -1; return; }
        grid = 256;
    }
    if (grid < 0) return;
    Args a{};
    for (int i = 0; i < 13; ++i) a.in[i] = (const float*)d_in[i];
    a.out = (float*)d_out; a.ws = (unsigned char*)d_ws;
#if ONE_LAUNCH
    a.ph_lo = 0; a.ph_hi = 8;
    void* kargs[] = {&a};
    hipError_t e = hipLaunchCooperativeKernel((void*)fwd, dim3(grid), dim3(NTHR), kargs, LDS_BYTES, stream);
    if (e != hipSuccess) fprintf(stderr, "cooperative launch failed: %s (grid %d)\n", hipGetErrorString(e), grid);
#else
    for (int p = 0; p < 8; ++p) { a.ph_lo = p; a.ph_hi = p + 1; hipLaunchKernelGGL(fwd, dim3(grid), dim3(NTHR), LDS_BYTES, stream, a); }
#endif
}
```

```cpp
#include <hip/hip_runtime.h>
#include <hip/hip_cooperative_groups.h>
#include <cstdio>
#include <cstdint>
#include <cmath>
namespace cg = cooperative_groups;
namespace pg8 {
#define PG8_LAS __attribute__((address_space(3)))
typedef unsigned short bf16_t;
typedef short bf16x8 __attribute__((ext_vector_type(8)));
typedef float f32x4 __attribute__((ext_vector_type(4)));
typedef unsigned u32x4 __attribute__((ext_vector_type(4)));
constexpr int BM = 256, BK = 64, HALF = 128, HTB = HALF * BK * 2  , STAGE_BYTES = 8 * HTB, NXCD = 8, WGM = 8;

__host__ __device__ __forceinline__ int lds_byte(int r, int c) { const int st = (r >> 4) * 2 + (c >> 5), rr = r & 15, cc = c & 31, ob = rr * 64 + cc * 2; return st * 1024 + (ob ^ (((ob >> 9) & 1) << 5)); }
__host__ __device__ __forceinline__ void stage_rc(int b, int& R, int& C) { const int st = b / 1024, sb = b % 1024, swz = sb ^ (((sb >> 9) & 1) << 5); R = (st >> 1) * 16 + swz / 64; C = (st & 1) * 32 + (swz % 64) / 2; }
__host__ __device__ __forceinline__ int perm32(int rho) { const int n = rho >> 4, i = rho & 15; return 8 * (i >> 2) + 4 * n + (i & 3); }

struct Unit { int pm, pn; };
struct Gemm { const bf16_t* A; const bf16_t* Bt; int M, N, K; };

struct StaticOrder {
    int nM, nN, nwg, G, c;
    __host__ __device__ void init(int M, int N, int G_, int c_) { nM = M / BM; nN = N / BM; nwg = nM * nN; G = G_; c = c_; }
    __host__ __device__ bool next(int i, Unit& u) const {
        const long L = (long)i * G + c; if (L >= nwg) return false;
        int wgid = (int)L; { const int q = nwg / NXCD, r = nwg % NXCD, xcd = wgid % NXCD, off = wgid / NXCD; wgid = (xcd < r ? xcd * (q + 1) : r * (q + 1) + (xcd - r) * q) + off; }
        const int nig = WGM * nN, gid = wgid / nig, fm = gid * WGM, gsz = (nM - fm) < WGM ? (nM - fm) : WGM;
        u.pm = fm + ((wgid % nig) % gsz); u.pn = (wgid % nig) / gsz; return true;
    }
    __device__ __forceinline__ void a_ready(const Unit&) const {}
    __device__ __forceinline__ void done(const Unit&) const {}
};

__device__ __forceinline__ unsigned cvt_pk_bf16(float lo, float hi) { unsigned r; asm volatile("v_cvt_pk_bf16_f32 %0, %1, %2" : "=v"(r) : "v"(lo), "v"(hi)); return r; }
typedef float f32x2 __attribute__((ext_vector_type(2)));
__device__ __forceinline__ f32x2 gelu_pk(f32x2 v) {
    const f32x2 av = __builtin_elementwise_abs(v), d = av * 0.2316418882f + 1.0f;
    f32x2 t; t.x = __builtin_amdgcn_rcpf(d.x); t.y = __builtin_amdgcn_rcpf(d.y);
    f32x2 q = t * 0.5307027145f + (-0.7265760135f); q = q * t + 0.7107068705f; q = q * t + (-0.142248368f); q = q * t + 0.127414796f; q = q * t;
    const f32x2 s = (v * v) * (-0.72134752044f);
    f32x2 e; e.x = __builtin_amdgcn_exp2f(s.x); e.y = __builtin_amdgcn_exp2f(s.y);
    const f32x2 m = v * (q * e), r = v - m;
    f32x2 o; o.x = v.x < 0.f ? m.x : r.x; o.y = v.y < 0.f ? m.y : r.y; return o;
}

template <int ACT  > struct EpiBf16 {
    static constexpr bool PERM = true, AFTER_DRAIN = false; static_assert(ACT == 0 || ACT == 1, "EpiBf16: ACT is 0 (none) or 1 (gelu_pk)");
    bf16_t* O; int ldc; const float* bias; int split_cols; size_t split_stride; float scale0;
    __device__ __forceinline__ void operator()(const f32x4 (&acc)[2][2][4][2], const Unit& u, int wr, int wc, int fr, int fq) const {
        const int row0 = u.pm * BM + wr * 64 + fr; int colt = u.pn * BM; bf16_t* base = O;
        float sc = 1.f; if (split_cols) { const int t = colt / split_cols; base += (size_t)t * split_stride; colt -= t * split_cols; if (t == 0) sc = scale0; }
        const int col0 = colt + wc * 32 + 8 * fq, bcol0 = u.pn * BM + wc * 32 + 8 * fq;
        f32x4 bv[2][2];
#pragma unroll
        for (int bj = 0; bj < 2; ++bj)
#pragma unroll
            for (int n = 0; n < 2; ++n) bv[bj][n] = bias ? *(const f32x4*)(bias + bcol0 + bj * HALF + 4 * n) : (f32x4){0.f, 0.f, 0.f, 0.f};
#pragma unroll
        for (int ai = 0; ai < 2; ++ai)
#pragma unroll
            for (int m = 0; m < 4; ++m) { bf16_t* rowp = base + (size_t)(row0 + ai * HALF + m * 16) * ldc + col0;
#pragma unroll
                for (int bj = 0; bj < 2; ++bj) { f32x4 v0 = acc[ai][bj][m][0] + bv[bj][0], v1 = acc[ai][bj][m][1] + bv[bj][1];
                    if (ACT == 1) { f32x2 a = gelu_pk((f32x2){v0[0], v0[1]}), b = gelu_pk((f32x2){v0[2], v0[3]}), c = gelu_pk((f32x2){v1[0], v1[1]}), d = gelu_pk((f32x2){v1[2], v1[3]});
                        v0 = (f32x4){a.x, a.y, b.x, b.y}; v1 = (f32x4){c.x, c.y, d.x, d.y}; }
                    v0 = v0 * sc; v1 = v1 * sc; u32x4 w; w.x = cvt_pk_bf16(v0[0], v0[1]); w.y = cvt_pk_bf16(v0[2], v0[3]); w.z = cvt_pk_bf16(v1[0], v1[1]); w.w = cvt_pk_bf16(v1[2], v1[3]);
                    *(u32x4*)(rowp + bj * HALF) = w; } }
    }
};

template <class Epi, class Sched, bool ALIGN_EPI = false, bool SP2 = false>
__device__ __forceinline__ void gemm_phase(PG8_LAS unsigned char* lds, const Gemm g, const Sched& S, const Epi& E) {
    const int tid = threadIdx.x, wid = __builtin_amdgcn_readfirstlane(tid >> 6), lane = tid & 63, wr = wid >> 2, wc = wid & 3, fr = lane & 15, fq = lane >> 4;
    const int K = g.K, nt = K / BK;
    unsigned voffA[2], voffB[2];
#pragma unroll
    for (int i = 0; i < 2; ++i) { int R, C; stage_rc(tid * 16 + i * 8192, R, C); const int Rb = Epi::PERM ? ((R & ~31) + perm32(R & 31)) : R;
        voffA[i] = (unsigned)(R * K + C) * 2u; voffB[i] = (unsigned)(Rb * K + C) * 2u; }
    const size_t kstep = (size_t)(BK * 2);
    const size_t hstep = (size_t)HALF * K * 2;
    const size_t tstep = 2 * hstep;
    const unsigned ldsw = (unsigned)wid * 1024u;
    const int aoff = lds_byte(wr * 64 + fr, fq * 8), boff = lds_byte(wc * 32 + fr, fq * 8);
#define PG8_SA(b, h) (((b) * 2 + (h)) * HTB)
#define PG8_SB(b, h) ((4 + (b) * 2 + (h)) * HTB)
#define PG8_STAGE(bufoff, gbase, voff) do { _Pragma("unroll") for (int _i = 0; _i < 2; ++_i) \
        __builtin_amdgcn_global_load_lds((const unsigned*)((const char*)(gbase) + (voff)[_i]), (PG8_LAS unsigned*)(lds + (bufoff) + ldsw + _i * 8192), 16, 0, 0); } while (0)
#define PG8_LDA(dst, b, h) do { _Pragma("unroll") for (int m = 0; m < 4; ++m) _Pragma("unroll") for (int k = 0; k < 2; ++k) dst[m][k] = *(const PG8_LAS bf16x8*)(lds + PG8_SA(b, h) + aoff + m * 2048 + k * 1024); } while (0)
#define PG8_LDB(dst, b, h) do { _Pragma("unroll") for (int n = 0; n < 2; ++n) _Pragma("unroll") for (int k = 0; k < 2; ++k) dst[n][k] = *(const PG8_LAS bf16x8*)(lds + PG8_SB(b, h) + boff + n * 2048 + k * 1024); } while (0)
#define PG8_MMA(ai, bj, At, Bt) do { __builtin_amdgcn_s_setprio(1); _Pragma("unroll") for (int m = 0; m < 4; ++m) _Pragma("unroll") for (int n = 0; n < 2; ++n) _Pragma("unroll") for (int k = 0; k < 2; ++k) \
        acc[ai][bj][m][n] = __builtin_amdgcn_mfma_f32_16x16x32_bf16(Bt[n][k], At[m][k], acc[ai][bj][m][n], 0, 0, 0); __builtin_amdgcn_s_setprio(0); } while (0)
#define PG8_WAIT_V(n) asm volatile("s_waitcnt vmcnt(" #n ")" ::: "memory")
#define PG8_WAIT_L(n) asm volatile("s_waitcnt lgkmcnt(" #n ")" ::: "memory")
#define PG8_BAR __builtin_amdgcn_s_barrier()
#define PG8_SCHED __builtin_amdgcn_sched_barrier(0)
    Unit cur, nxt; int ui = 0;
    if (!S.next(0, cur)) return;
    f32x4 acc[2][2][4][2];
#pragma unroll
    for (int a = 0; a < 2; ++a)
#pragma unroll
        for (int b = 0; b < 2; ++b)
#pragma unroll
            for (int m = 0; m < 4; ++m)
#pragma unroll
                for (int n = 0; n < 2; ++n) acc[a][b][m][n] = (f32x4){0.f, 0.f, 0.f, 0.f};
    bf16x8 At[4][2], B0[2][2], B1[2][2];
    const char* cA = (const char*)g.A + (size_t)cur.pm * tstep; const char* cB = (const char*)g.Bt + (size_t)cur.pn * tstep;
    S.a_ready(cur);
    if constexpr (SP2) {
        PG8_STAGE(PG8_SB(0, 0), cB, voffB); PG8_STAGE(PG8_SB(0, 1), cB + hstep, voffB); PG8_STAGE(PG8_SA(0, 0), cA, voffA); PG8_STAGE(PG8_SA(0, 1), cA + hstep, voffA);
        if (wr == 1) PG8_BAR;
        PG8_WAIT_V(2); PG8_BAR;
        PG8_STAGE(PG8_SB(1, 0), cB + kstep, voffB); PG8_STAGE(PG8_SA(1, 0), cA + kstep, voffA); PG8_STAGE(PG8_SB(1, 1), cB + hstep + kstep, voffB);
        PG8_WAIT_V(6); PG8_BAR;
    } else {
        PG8_STAGE(PG8_SB(0, 0), cB, voffB); PG8_STAGE(PG8_SA(0, 0), cA, voffA); PG8_STAGE(PG8_SB(0, 1), cB + hstep, voffB); PG8_STAGE(PG8_SA(0, 1), cA + hstep, voffA);
        if (wr == 1) PG8_BAR;
        PG8_WAIT_V(4); PG8_BAR;
        PG8_STAGE(PG8_SB(1, 0), cB + kstep, voffB); PG8_STAGE(PG8_SA(1, 0), cA + kstep, voffA); PG8_STAGE(PG8_SB(1, 1), cB + hstep + kstep, voffB);
        PG8_WAIT_V(6); PG8_BAR;
    }
    for (;;) {
        const bool has_next = S.next(ui + 1, nxt);
        const char* nA = has_next ? (const char*)g.A + (size_t)nxt.pm * tstep : cA; const char* nB = has_next ? (const char*)g.Bt + (size_t)nxt.pn * tstep : cB;
        for (int t = 0; t < nt; t += 2) {
            const bool last = (t == nt - 2);
            const char* a1 = cA + (size_t)(t + 1) * kstep;
            const char* a2 = last ? nA : cA + (size_t)(t + 2) * kstep; const char* b2 = last ? nB : cB + (size_t)(t + 2) * kstep;
            const char* a3 = a2 + kstep; const char* b3 = b2 + kstep;
            if (last && has_next) S.a_ready(nxt);
            if constexpr (SP2) {
            PG8_LDB(B0, 0, 0); PG8_LDB(B1, 0, 1); PG8_SCHED; PG8_LDA(At, 0, 0); PG8_STAGE(PG8_SA(1, 1), a1 + hstep, voffA);
            PG8_WAIT_V(8); PG8_WAIT_L(0); PG8_BAR; PG8_MMA(0, 0, At, B0); PG8_MMA(0, 1, At, B1); PG8_BAR; PG8_SCHED;
            PG8_LDA(At, 0, 1); PG8_STAGE(PG8_SB(0, 0), b2, voffB); PG8_STAGE(PG8_SB(0, 1), b2 + hstep, voffB); PG8_STAGE(PG8_SA(0, 0), a2, voffA);
            PG8_WAIT_V(8); PG8_WAIT_L(0); PG8_BAR; PG8_MMA(1, 0, At, B0); PG8_MMA(1, 1, At, B1); PG8_BAR; PG8_SCHED;
            PG8_LDB(B0, 1, 0); PG8_LDB(B1, 1, 1); PG8_SCHED; PG8_LDA(At, 1, 0); PG8_STAGE(PG8_SA(0, 1), a2 + hstep, voffA);
            PG8_WAIT_V(8); PG8_WAIT_L(0); PG8_BAR; PG8_MMA(0, 0, At, B0); PG8_MMA(0, 1, At, B1); PG8_BAR; PG8_SCHED;
            PG8_LDA(At, 1, 1); PG8_STAGE(PG8_SB(1, 0), b3, voffB); PG8_STAGE(PG8_SB(1, 1), b3 + hstep, voffB); PG8_STAGE(PG8_SA(1, 0), a3, voffA);
            PG8_WAIT_V(8); PG8_WAIT_L(0); PG8_BAR; PG8_MMA(1, 0, At, B0); PG8_MMA(1, 1, At, B1); PG8_BAR; PG8_SCHED;
            } else {
            PG8_LDB(B0, 0, 0); PG8_SCHED; PG8_LDA(At, 0, 0); PG8_STAGE(PG8_SA(1, 1), a1 + hstep, voffA);
            PG8_WAIT_L(8); PG8_BAR; PG8_WAIT_L(0); PG8_MMA(0, 0, At, B0); PG8_BAR; PG8_SCHED;
            PG8_LDB(B1, 0, 1); PG8_STAGE(PG8_SB(0, 0), b2, voffB);
            PG8_BAR; PG8_WAIT_L(0); PG8_MMA(0, 1, At, B1); PG8_BAR;
            PG8_LDA(At, 0, 1); PG8_STAGE(PG8_SA(0, 0), a2, voffA);
            PG8_BAR; PG8_WAIT_L(0); PG8_MMA(1, 0, At, B0); PG8_BAR; PG8_SCHED;
            PG8_STAGE(PG8_SB(0, 1), b2 + hstep, voffB);
            PG8_WAIT_V(6); PG8_BAR; PG8_MMA(1, 1, At, B1); PG8_BAR;
            PG8_LDB(B0, 1, 0); PG8_SCHED; PG8_LDA(At, 1, 0); PG8_STAGE(PG8_SA(0, 1), a2 + hstep, voffA);
            PG8_WAIT_L(8); PG8_BAR; PG8_WAIT_L(0); PG8_MMA(0, 0, At, B0); PG8_BAR; PG8_SCHED;
            PG8_LDB(B1, 1, 1); PG8_STAGE(PG8_SB(1, 0), b3, voffB);
            PG8_BAR; PG8_WAIT_L(0); PG8_MMA(0, 1, At, B1); PG8_BAR;
            PG8_LDA(At, 1, 1); PG8_STAGE(PG8_SA(1, 0), a3, voffA);
            PG8_BAR; PG8_WAIT_L(0); PG8_MMA(1, 0, At, B0); PG8_BAR; PG8_SCHED;
            PG8_STAGE(PG8_SB(1, 1), b3 + hstep, voffB);
            PG8_WAIT_V(6); PG8_BAR; PG8_MMA(1, 1, At, B1); PG8_BAR;
            }
        }
        if constexpr (ALIGN_EPI) { if (wr == 0) PG8_BAR; }
        if constexpr (!Epi::AFTER_DRAIN) { E(acc, cur, wr, wc, fr, fq); S.done(cur); }
        if (!has_next) break;
#pragma unroll
        for (int a = 0; a < 2; ++a)
#pragma unroll
            for (int b = 0; b < 2; ++b)
#pragma unroll
                for (int m = 0; m < 4; ++m)
#pragma unroll
                    for (int n = 0; n < 2; ++n) acc[a][b][m][n] = (f32x4){0.f, 0.f, 0.f, 0.f};
        cur = nxt; cA = nA; cB = nB; ++ui;
        if constexpr (ALIGN_EPI) { if (wr == 1) PG8_BAR; }
    }
    PG8_WAIT_V(0);
    if constexpr (!ALIGN_EPI) { if (wr == 0) PG8_BAR; }
    PG8_BAR;
    if constexpr (Epi::AFTER_DRAIN) { E.fused(acc, cur, wr, wc, fr, fq, lds, wid, lane); S.done(cur); }
#undef PG8_SA
#undef PG8_SB
#undef PG8_STAGE
#undef PG8_LDA
#undef PG8_LDB
#undef PG8_MMA
#undef PG8_WAIT_V
#undef PG8_WAIT_L
#undef PG8_BAR
#undef PG8_SCHED
}
}

#ifndef PG8_SP2
#define PG8_SP2 true
#endif
#ifndef PG8_ALIGN
#define PG8_ALIGN true
#endif
#ifndef SKIPMASK
#define SKIPMASK 0
#endif
#ifndef REPMASK
#define REPMASK 0
#endif
#ifndef EXTRA_SYNCS
#define EXTRA_SYNCS 0
#endif
#ifndef ONE_LAUNCH
#define ONE_LAUNCH 1
#endif
constexpr int NB = 8, SEQ = 2048, D = 1024, FF = 4096, M = NB * SEQ;
constexpr int NMETA = 16, MR = M + NMETA;
constexpr int PW = 3088, NP = 3072;
constexpr int C_Q = 0, C_K = 256, C_V = 512, C_G = 1024, C_CB = 1536, C_CC = 2048, C_CX = 2560;
constexpr int SRC_GR = 1536;
constexpr float EPS = 1e-6f;
constexpr size_t MiB = 1u << 20;
constexpr size_t WS_SS1 = 0, WS_SS2 = 256 * 1024;
constexpr size_t WS_WIN = 1 * MiB, WS_WOUT = 7 * MiB, WS_WUP = 9 * MiB, WS_WDN = 17 * MiB;
constexpr size_t WS_GR = 25 * MiB;
constexpr size_t WS_AGG = 27 * MiB, WS_DG = 35 * MiB;
constexpr size_t WS_XN = 36 * MiB;
constexpr size_t WS_PROJ = 68 * MiB;
constexpr size_t WS_MIX = 166 * MiB;
constexpr size_t WS_HB = 68 * MiB;
constexpr size_t WS_BAR = 512 * 1024, BAR_BYTES = 16384;
constexpr int LDS_BYTES = 147456, MISC_OFF = LDS_BYTES - 64;
constexpr int NWAVES = 8, NTHR = 512;

#define LAS __attribute__((address_space(3)))
typedef unsigned short bf16;
typedef unsigned v4u __attribute__((ext_vector_type(4)));
typedef unsigned v2u __attribute__((ext_vector_type(2)));
typedef float f32x4 __attribute__((ext_vector_type(4)));
#define LDS_WAIT() asm volatile("s_waitcnt lgkmcnt(0)" ::: "memory")
__device__ __forceinline__ unsigned f2bf(float f) { unsigned u = __builtin_bit_cast(unsigned, f); return (u + 0x7fffu + ((u >> 16) & 1u)) >> 16; }
__device__ __forceinline__ unsigned pk2(float lo, float hi) { return f2bf(lo) | (f2bf(hi) << 16); }
__device__ __forceinline__ float bflo(unsigned u) { return __builtin_bit_cast(float, u << 16); }
__device__ __forceinline__ float bfhi(unsigned u) { return __builtin_bit_cast(float, u & 0xffff0000u); }
__device__ __forceinline__ void unpack8(v4u p, float (&o)[8]) { o[0] = bflo(p.x); o[1] = bfhi(p.x); o[2] = bflo(p.y); o[3] = bfhi(p.y); o[4] = bflo(p.z); o[5] = bfhi(p.z); o[6] = bflo(p.w); o[7] = bfhi(p.w); }
__device__ __forceinline__ float wave_sum(float v) {
#pragma unroll
    for (int o = 1; o < 64; o <<= 1) v += __shfl_xor(v, o);
    return v;
}

template <bool WB> struct EpiRes {
    static constexpr bool PERM = false, AFTER_DRAIN = true;
    const float* base; float* out; pg8::bf16_t* hb; float* ss;
    __device__ __forceinline__ void fused(pg8::f32x4 (&acc)[2][2][4][2], const pg8::Unit& u, int wr, int wc, int fr, int fq, LAS unsigned char* lds, int wid, int lane) const {
        LAS float* P = (LAS float*)lds;
        const int col0 = u.pn * 256 + wc * 32 + 4 * fq;
#pragma unroll
        for (int ai = 0; ai < 2; ++ai)
#pragma unroll
            for (int m = 0; m < 4; ++m) {
                const int r = ai * 128 + wr * 64 + m * 16 + fr; const size_t off = (size_t)(u.pm * 256 + r) * D + col0; float s = 0.f;
#pragma unroll
                for (int bj = 0; bj < 2; ++bj)
#pragma unroll
                    for (int n = 0; n < 2; ++n) {
                        const f32x4 bs = *(const f32x4*)(base + off + bj * 128 + n * 16); const f32x4 v = acc[ai][bj][m][n] + bs;
                        *(f32x4*)(out + off + bj * 128 + n * 16) = v; s += (v[0] * v[0] + v[1] * v[1]) + (v[2] * v[2] + v[3] * v[3]);
                        if (WB) { v2u w; w.x = pk2(v[0], v[1]); w.y = pk2(v[2], v[3]); *(v2u*)(hb + off + bj * 128 + n * 16) = w; }
                    }
                s += __shfl_xor(s, 16); s += __shfl_xor(s, 32);
                if (fq == 0) P[r * 4 + wc] = s;
                if (m & 1) asm volatile("" ::: "memory");
            }
        __syncthreads();
        const int tid = wid * 64 + lane;
        if (tid < 256) { const f32x4 p = *(const LAS f32x4*)(P + tid * 4); ss[(size_t)(u.pm * 256 + tid) * 4 + u.pn] = (p[0] + p[1]) + (p[2] + p[3]); }
    }
};
struct EpiUp {
    static constexpr bool PERM = true, AFTER_DRAIN = false;
    pg8::bf16_t* O; int ldc; const float* ss;
    __device__ __forceinline__ void operator()(const pg8::f32x4 (&acc)[2][2][4][2], const pg8::Unit& u, int wr, int wc, int fr, int fq) const {
        const int row0 = u.pm * 256 + wr * 64 + fr, col0 = u.pn * 256 + wc * 32 + 8 * fq;
#pragma unroll
        for (int ai = 0; ai < 2; ++ai)
#pragma unroll
            for (int m = 0; m < 4; ++m) {
                const int row = row0 + ai * 128 + m * 16; const f32x4 s4 = *(const f32x4*)(ss + (size_t)row * 4);
                const float rstd = __builtin_amdgcn_rsqf(((s4[0] + s4[1]) + (s4[2] + s4[3])) * (1.0f / D) + EPS);
                pg8::bf16_t* rowp = O + (size_t)row * ldc + col0;
#pragma unroll
                for (int bj = 0; bj < 2; ++bj) {
                    f32x4 v0 = acc[ai][bj][m][0] * rstd, v1 = acc[ai][bj][m][1] * rstd;
#pragma unroll
                    for (int e = 0; e < 4; ++e) { const float a = fmaxf(v0[e], 0.f), b = fmaxf(v1[e], 0.f); v0[e] = a * a; v1[e] = b * b; }
                    v4u w; w.x = pg8::cvt_pk_bf16(v0[0], v0[1]); w.y = pg8::cvt_pk_bf16(v0[2], v0[3]); w.z = pg8::cvt_pk_bf16(v1[0], v1[1]); w.w = pg8::cvt_pk_bf16(v1[2], v1[3]);
                    *(v4u*)(rowp + bj * 128) = w;
                }
            }
    }
};

#define RLX_AGENT __ATOMIC_RELAXED, __HIP_MEMORY_SCOPE_AGENT
#define XB_TMO      128
#define XB_XCNT(j)  (256  + 64 * (j))
#define XB_XSUB(j)  (1280 + 64 * (j))
#define XB_XGEN(j)  (2304 + 64 * (j))
#define XB_TOP      3328
#define XB_TOPGEN   3392
#define XCD_BAR_WORDS 3456
#define XB_SPIN_CAP (1u << 18)

__device__ __forceinline__ unsigned xb_ld(unsigned* p)              { return __hip_atomic_load(p, __ATOMIC_RELAXED, __HIP_MEMORY_SCOPE_AGENT); }
__device__ __forceinline__ unsigned xb_add(unsigned* p, unsigned v) { return __hip_atomic_fetch_add(p, v, __ATOMIC_RELAXED, __HIP_MEMORY_SCOPE_AGENT); }
__device__ __forceinline__ unsigned xb_xcc_id() { return (unsigned)__builtin_amdgcn_s_getreg((3 << 11) | 20) & 0xFu; }
#define XB_SPIN(cond, bar) do { unsigned _sp = 0; while (cond) { __builtin_amdgcn_s_sleep(1); \
    if ((++_sp & 255u) == 0u) { if (xb_ld(&(bar)[XB_TMO])) break; if (_sp > XB_SPIN_CAP) { atomicAdd(&(bar)[XB_TMO], 1u); break; } } } } while (0)

struct XcdBarrier {
    unsigned* bar; unsigned x;
    volatile LAS unsigned* st;
};

__device__ __forceinline__ XcdBarrier xcd_barrier_post(unsigned* bar, volatile LAS unsigned* st) {
    XcdBarrier b; b.bar = bar; b.x = xb_xcc_id(); b.st = st;
    if (threadIdx.x == 0) (void)xb_add(&bar[XB_XCNT(b.x)], 1u);
    return b;
}
__device__ __forceinline__ void xcd_barrier_complete(unsigned* bar, unsigned x, unsigned& nloc, unsigned& nx) {
    const unsigned G = gridDim.x * gridDim.y * gridDim.z;
    unsigned sum, cnt, mine, sp = 0u;
    for (;;) {
        sum = 0u; cnt = 0u; mine = 0u;
#pragma unroll
        for (unsigned j = 0; j < 16; ++j) { const unsigned c = xb_ld(&bar[XB_XCNT(j)]); sum += c; cnt += (c > 0u) ? 1u : 0u; mine = (j == x) ? c : mine; }
        if (sum == G) break;
        __builtin_amdgcn_s_sleep(1);
        if ((++sp & 255u) == 0u) { if (xb_ld(&bar[XB_TMO])) break; if (sp > XB_SPIN_CAP) { atomicAdd(&bar[XB_TMO], 1u); break; } }
    }
    nloc = mine > 0u ? mine : 1u; nx = cnt > 0u ? cnt : 1u;
}

__device__ __forceinline__ void xcd_barrier(const XcdBarrier& b) {
    asm volatile("s_waitcnt vmcnt(0)" ::: "memory");
    __syncthreads();
    if (threadIdx.x == 0) {
        unsigned* bar = b.bar;
        __builtin_amdgcn_s_waitcnt(0);
        unsigned nloc = b.st[0], nx = b.st[1];
        if (nloc == 0u) { xcd_barrier_complete(bar, b.x, nloc, nx); b.st[0] = nloc; b.st[1] = nx; }
        const unsigned old = xb_add(&bar[XB_XSUB(b.x)], 1u);
        const unsigned gen = old / nloc;
        if (old + 1u == (gen + 1u) * nloc) {
            __builtin_amdgcn_fence(__ATOMIC_RELEASE, "agent");
            asm volatile("s_waitcnt vmcnt(0)" ::: "memory");
            const unsigned og = xb_add(&bar[XB_TOP], 1u);
            const unsigned tg = og / nx;
            if (og + 1u == (tg + 1u) * nx) xb_add(&bar[XB_TOPGEN], 1u);
            else XB_SPIN(xb_ld(&bar[XB_TOPGEN]) == tg, bar);
            __builtin_amdgcn_fence(__ATOMIC_ACQUIRE, "agent");
            xb_add(&bar[XB_XGEN(b.x)], 1u);
            asm volatile("s_waitcnt vmcnt(0)" ::: "memory");
        } else {
            XB_SPIN(xb_ld(&bar[XB_XGEN(b.x)]) == gen, bar);
            __builtin_amdgcn_fence(__ATOMIC_ACQUIRE, "agent");
            asm volatile("s_waitcnt vmcnt(0)" ::: "memory");
        }
    }
    __syncthreads();
}

struct Args { const float* in[13]; float* out; unsigned char* ws; int ph_lo, ph_hi; };
struct Frame {
    LAS unsigned char* lds; int tid, lane, wave, G, bx;
    const float *x, *meta, *nmix, *win, *wgu, *bgate, *gnw, *convw, *wout, *nmlp, *wup, *wdn, *nfin; float* out;
    bf16 *WinT, *WoutT, *WupT, *WdnT, *XN, *PROJ, *MIX, *HB; float *GR, *AGG, *DG, *SS1, *SS2;
};

__device__ __forceinline__ void p0_transpose_item(const float* W, int ldw, int K, bf16* WT, int n0, int sc0, int k0, const float* kscale, float cscale, LAS float* scr, int lane) {
#pragma unroll 8
    for (int i = 0; i < 32; ++i) { const int kk = 2 * i + (lane >> 5); float s = cscale; if (kscale) s *= kscale[k0 + kk]; scr[kk * 33 + (lane & 31)] = W[(size_t)(k0 + kk) * ldw + sc0 + (lane & 31)] * s; }
    LDS_WAIT(); asm volatile("" ::: "memory");
    const int c = lane & 7;
#pragma unroll
    for (int j = 0; j < 4; ++j) { const int n = (lane >> 3) + 8 * j; const LAS float* s = scr + (8 * c) * 33 + n;
        v4u o; o.x = pk2(s[0 * 33], s[1 * 33]); o.y = pk2(s[2 * 33], s[3 * 33]); o.z = pk2(s[4 * 33], s[5 * 33]); o.w = pk2(s[6 * 33], s[7 * 33]);
        *(v4u*)(WT + (size_t)(n0 + n) * K + k0 + 8 * c) = o; }
    LDS_WAIT(); asm volatile("" ::: "memory");
}
__device__ __forceinline__ void p0_prologue(Frame& F) {
    const int tid = F.tid, lane = F.lane, wave = F.wave;
    if (F.bx < 28) {
        LAS float* xm = (LAS float*)F.lds;
        LAS float* red = xm + 16384;
#pragma unroll
        for (int rr = 0; rr < 2; ++rr) {
            const int r = 2 * wave + rr; const f32x4* xr = (const f32x4*)(F.meta + (size_t)r * D) + lane; const f32x4* nw = (const f32x4*)F.nmix + lane;
            f32x4 v[4]; float s = 0.f;
#pragma unroll
            for (int j = 0; j < 4; ++j) { v[j] = xr[64 * j]; s += (v[j][0] * v[j][0] + v[j][1] * v[j][1]) + (v[j][2] * v[j][2] + v[j][3] * v[j][3]); }
            const float rstd = 1.0f / sqrtf(wave_sum(s) * (1.0f / D) + EPS);
#pragma unroll
            for (int j = 0; j < 4; ++j) { const f32x4 w4 = nw[64 * j];
#pragma unroll
                for (int i = 0; i < 4; ++i) xm[(256 * j + 4 * lane + i) * 16 + r] = v[j][i] * rstd * w4[i]; }
        }
        __syncthreads();
        {
            const int j = F.bx * 64 + lane; const int pc = j < 768 ? 256 + j : 2048 + (j - 768); const int sc = pc < 1536 ? pc : pc + 16;
            float acc[16];
#pragma unroll
            for (int r = 0; r < 16; ++r) acc[r] = 0.f;
            const float* wp = F.win + (size_t)(128 * wave) * PW + sc;
#pragma unroll 4
            for (int k = 0; k < 128; ++k) {
                const float wv = wp[(size_t)k * PW]; const LAS f32x4* xp = (const LAS f32x4*)(xm + (128 * wave + k) * 16);
#pragma unroll
                for (int q = 0; q < 4; ++q) { const f32x4 x4 = xp[q];
#pragma unroll
                    for (int i = 0; i < 4; ++i) acc[4 * q + i] += x4[i] * wv; }
            }
#pragma unroll
            for (int r = 0; r < 16; ++r) red[(wave * 16 + r) * 64 + lane] = acc[r];
        }
        __syncthreads();
#pragma unroll
        for (int i = 0; i < 2; ++i) {
            const int o = tid + 512 * i, r = o >> 6, l = o & 63; float s = 0.f;
#pragma unroll
            for (int w = 0; w < 8; ++w) s += red[(w * 16 + r) * 64 + l];
            const int j = F.bx * 64 + l; const int pc = j < 768 ? 256 + j : 2048 + (j - 768);
            F.PROJ[(size_t)(M + r) * NP + pc] = (bf16)f2bf(s);
        }
        __syncthreads();
    }
    {
        LAS float* scr = (LAS float*)(F.lds + wave * 16384);
        const int gw = F.bx * NWAVES + wave, NGW = F.G * NWAVES;
        constexpr int I_IN = 16 * 96, I_OUT = 16 * 32, I_UP = 16 * 128, I_DN = 64 * 32, NITEMS = I_IN + I_OUT + I_UP + I_DN;
        for (int it = gw; it < NITEMS; it += NGW) {
            int r = it;
            if (r < I_IN) { const int kb = r / 96, nb = r % 96, n0 = 32 * nb; p0_transpose_item(F.win, PW, D, F.WinT, n0, n0 < 1536 ? n0 : n0 + 16, 64 * kb, nullptr, n0 < 256 ? 0.125f : 1.0f, scr, lane); continue; } r -= I_IN;
            if (r < I_OUT) { const int kb = r / 32, nb = r % 32; p0_transpose_item(F.wout, D, D, F.WoutT, 32 * nb, 32 * nb, 64 * kb, nullptr, 1.0f, scr, lane); continue; } r -= I_OUT;
            if (r < I_UP) { const int kb = r / 128, nb = r % 128; p0_transpose_item(F.wup, FF, D, F.WupT, 32 * nb, 32 * nb, 64 * kb, F.nmlp, 1.0f, scr, lane); continue; } r -= I_UP;
            { const int kb = r / 32, nb = r % 32; p0_transpose_item(F.wdn, D, FF, F.WdnT, 32 * nb, 32 * nb, 64 * kb, nullptr, 1.0f, scr, lane); }
        }
    }
    __syncthreads();
    {
        LAS f32x4* T = (LAS f32x4*)F.lds;
#pragma unroll
        for (int i = 0; i < 8; ++i) { const int e = tid + 512 * i, ln = e & 63, c4 = (e >> 6) & 3, kg = e >> 8; const int k = 256 * (kg >> 2) + 4 * ln + (kg & 3);
            T[e] = *(const f32x4*)(F.win + (size_t)k * PW + SRC_GR + 4 * c4); }
        __syncthreads();
        const int gw = F.bx * NWAVES + wave, NGW = F.G * NWAVES;
        const f32x4* nw = (const f32x4*)F.nmix + lane;
        f32x4 nw4[4];
#pragma unroll
        for (int j = 0; j < 4; ++j) nw4[j] = nw[64 * j];
        for (int m = gw; m < MR; m += NGW) {
            asm volatile("" ::: "memory");
            const f32x4* xr = (const f32x4*)(m < M ? F.x + (size_t)m * D : F.meta + (size_t)(m - M) * D) + lane;
            f32x4 v[4]; float s = 0.f;
#pragma unroll
            for (int j = 0; j < 4; ++j) { v[j] = xr[64 * j]; s += (v[j][0] * v[j][0] + v[j][1] * v[j][1]) + (v[j][2] * v[j][2] + v[j][3] * v[j][3]); }
            const float rstd = 1.0f / sqrtf(wave_sum(s) * (1.0f / D) + EPS);
#pragma unroll
            for (int j = 0; j < 4; ++j) v[j] = v[j] * rstd * nw4[j];
            if (m < M) { unsigned long long* o8 = (unsigned long long*)(F.XN + (size_t)m * D) + lane;
#pragma unroll
                for (int j = 0; j < 4; ++j) o8[64 * j] = (unsigned long long)pk2(v[j][0], v[j][1]) | ((unsigned long long)pk2(v[j][2], v[j][3]) << 32); }
            float acc[16];
#pragma unroll
            for (int c = 0; c < 16; ++c) acc[c] = 0.f;
#pragma unroll
            for (int kg = 0; kg < 16; ++kg) { const float xv = v[kg >> 2][kg & 3];
#pragma unroll
                for (int c4 = 0; c4 < 4; ++c4) { const f32x4 w4 = T[(kg * 4 + c4) * 64 + lane];
#pragma unroll
                    for (int i = 0; i < 4; ++i) acc[4 * c4 + i] += xv * w4[i]; } }
            float r8[8], r4[4], r2[2], r1;
#pragma unroll
            for (int i = 0; i < 8; ++i) { const bool up = lane & 32; const float send = up ? acc[i] : acc[i + 8], keep = up ? acc[i + 8] : acc[i]; r8[i] = keep + __shfl_xor(send, 32); }
#pragma unroll
            for (int i = 0; i < 4; ++i) { const bool up = lane & 16; const float send = up ? r8[i] : r8[i + 4], keep = up ? r8[i + 4] : r8[i]; r4[i] = keep + __shfl_xor(send, 16); }
#pragma unroll
            for (int i = 0; i < 2; ++i) { const bool up = lane & 8; const float send = up ? r4[i] : r4[i + 2], keep = up ? r4[i + 2] : r4[i]; r2[i] = keep + __shfl_xor(send, 8); }
            { const bool up = lane & 4; const float send = up ? r2[0] : r2[1], keep = up ? r2[1] : r2[0]; r1 = keep + __shfl_xor(send, 4); }
            r1 += __shfl_xor(r1, 2); r1 += __shfl_xor(r1, 1);
            if ((lane & 3) == 0) F.GR[(size_t)m * 16 + (lane >> 2)] = r1;
        }
    }
    __syncthreads();
}

__device__ __forceinline__ LAS float* opq(LAS float* p) { asm volatile("" : "+v"(p)); return p; }
constexpr int LS = 68;
constexpr int L_QBT = 0, L_KBT = 4352, L_AT = 8704, L_KD = 13056, L_V = 17408, L_H = 25600, L_EBL = 33792, L_WG = 33856, L_BG = 34880;
static_assert((L_BG + 64) * 4 <= LDS_BYTES, "GLA LDS map");

template <bool FULL>
__device__ __forceinline__ void gla_stage_a(LAS float* L, const bf16* PROJ, const float* GR, int hh, bool meta, size_t m0, int tid) {
    asm volatile("" ::: "memory");
    const int w = tid >> 6, t = tid & 63;
    const bool valid = !meta || t >= 48;
    const size_t row = meta ? (size_t)(M + (valid ? t - 48 : 0)) : m0 + t;
    float gr[16];
    { const f32x4* gp = (const f32x4*)(GR + row * 16);
#pragma unroll
        for (int q = 0; q < 4; ++q) { f32x4 g4 = gp[q]; gr[4 * q] = g4[0]; gr[4 * q + 1] = g4[1]; gr[4 * q + 2] = g4[2]; gr[4 * q + 3] = g4[3]; } }
    float b[8];
    { const f32x4 z0 = *(const LAS f32x4*)(L + L_BG + 8 * w), z1 = *(const LAS f32x4*)(L + L_BG + 8 * w + 4);
      b[0] = z0[0]; b[1] = z0[1]; b[2] = z0[2]; b[3] = z0[3]; b[4] = z1[0]; b[5] = z1[1]; b[6] = z1[2]; b[7] = z1[3]; }
#pragma unroll
    for (int r = 0; r < 16; ++r) { const f32x4 w0 = *(const LAS f32x4*)(L + L_WG + r * 64 + 8 * w), w1 = *(const LAS f32x4*)(L + L_WG + r * 64 + 8 * w + 4);
#pragma unroll
        for (int i = 0; i < 4; ++i) { b[i] += gr[r] * w0[i]; b[4 + i] += gr[r] * w1[i]; }
        if ((r & 3) == 3) asm volatile("" ::: "memory"); }
#pragma unroll
    for (int i = 0; i < 8; ++i) { const float z = b[i]; const float ls = fminf(z, 0.f) - log1pf(__expf(-fabsf(z))); b[i] = valid ? ls * (1.0f / 16.0f) : 0.f; }
#pragma unroll
    for (int off = 1; off < 64; off <<= 1) {
#pragma unroll
        for (int i = 0; i < 8; ++i) { const float tmp = __shfl_up(b[i], off); if (t >= off) b[i] += tmp; } }
    v4u k8 = (v4u){0u, 0u, 0u, 0u}, q8 = (v4u){0u, 0u, 0u, 0u};
    if (valid) { k8 = *(const v4u*)(PROJ + row * NP + C_K + hh * 64 + 8 * w); if (FULL) q8 = *(const v4u*)(PROJ + row * NP + C_Q + hh * 64 + 8 * w); }
    float kf[8], qf[8]; unpack8(k8, kf); unpack8(q8, qf);
    float kdv[8];
#pragma unroll
    for (int i = 0; i < 8; ++i) { const int d = 8 * w + i; const float bl = __shfl(b[i], 63);
        kdv[i] = kf[i] * __expf(bl - b[i]);
        if (FULL) { L[L_QBT + d * LS + t] = qf[i] * __expf(b[i]); L[L_KBT + d * LS + t] = kf[i] * __expf(-b[i]); }
        if (t == 0) L[L_EBL + d] = __expf(bl); }
    *(LAS f32x4*)(L + L_KD + t * LS + 8 * w) = (f32x4){kdv[0], kdv[1], kdv[2], kdv[3]};
    *(LAS f32x4*)(L + L_KD + t * LS + 8 * w + 4) = (f32x4){kdv[4], kdv[5], kdv[6], kdv[7]};
#pragma unroll
    for (int i = 0; i < 2; ++i) { const int e = tid + 512 * i, tok = e >> 4, piece = e & 15; const bool vv = !meta || tok >= 48;
        const size_t rv = meta ? (size_t)(M + (vv ? tok - 48 : 0)) : m0 + tok;
        v4u p = (v4u){0u, 0u, 0u, 0u}; if (vv) p = *(const v4u*)(PROJ + rv * NP + C_V + hh * 128 + 8 * piece);
        float f[8]; unpack8(p, f);
        *(LAS f32x4*)(L + L_V + tok * 128 + 8 * piece) = (f32x4){f[0], f[1], f[2], f[3]};
        *(LAS f32x4*)(L + L_V + tok * 128 + 8 * piece + 4) = (f32x4){f[4], f[5], f[6], f[7]}; }
}
__device__ __forceinline__ void gla_delta(const LAS float* L, int c, int ig, float (&dl)[16]) {
#pragma unroll
    for (int dd = 0; dd < 16; ++dd) dl[dd] = 0.f;
#pragma unroll 4
    for (int t = 0; t < 64; ++t) { const float vv = L[L_V + t * 128 + c]; const LAS f32x4* kp = (const LAS f32x4*)(L + L_KD + t * LS + 16 * ig);
#pragma unroll
        for (int q = 0; q < 4; ++q) { const f32x4 k4 = kp[q];
#pragma unroll
            for (int i = 0; i < 4; ++i) dl[4 * q + i] += k4[i] * vv; } }
}
__device__ __forceinline__ void gla_state_chunk(LAS float* L, const Frame& F, int hh, bool meta, size_t m0, float (&hreg)[16], float& dprod) {
    const int tid = F.tid, c = tid & 127, ig = tid >> 7;
    gla_stage_a<false>(L, F.PROJ, F.GR, hh, meta, m0, tid);
    __syncthreads();
    float dl[16]; gla_delta(L, c, ig, dl);
    const LAS float* ebp = opq(L + L_EBL + 16 * ig);
#pragma unroll
    for (int dd = 0; dd < 16; ++dd) hreg[dd] = ebp[dd] * hreg[dd] + dl[dd];
    if (tid < 64) dprod *= ebp[tid - 16 * ig];
    __syncthreads();
}
__device__ __forceinline__ void gla_load_gate(LAS float* L, const Frame& F, int hh) {
    for (int e = F.tid; e < 1024; e += NTHR) L[L_WG + e] = F.wgu[(e >> 6) * 256 + hh * 64 + (e & 63)];
    if (F.tid < 64) L[L_BG + F.tid] = F.bgate[hh * 64 + F.tid];
}
__device__ __forceinline__ void p2a_phase(Frame& F) {
    LAS float* L = (LAS float*)F.lds;
    for (int u = F.bx; u < 256; u += F.G) {
        const int g = u & 7, hh = (u >> 3) & 3, b = u >> 5;
        if (g == 7) continue;
        gla_load_gate(L, F, hh);
        __syncthreads();
        float hreg[16]; float dprod = 1.f;
#pragma unroll
        for (int dd = 0; dd < 16; ++dd) hreg[dd] = 0.f;
        if (g == 0) gla_state_chunk(L, F, hh, true, 0, hreg, dprod);
        for (int cc = 0; cc < 4; ++cc) gla_state_chunk(L, F, hh, false, (size_t)b * SEQ + (size_t)(4 * g + cc) * 64, hreg, dprod);
        f32x4* ap = (f32x4*)(F.AGG + ((size_t)u * NTHR + F.tid) * 16);
#pragma unroll
        for (int q = 0; q < 4; ++q) ap[q] = (f32x4){hreg[4 * q], hreg[4 * q + 1], hreg[4 * q + 2], hreg[4 * q + 3]};
        if (F.tid < 64) F.DG[u * 64 + F.tid] = dprod;
    }
}
__device__ __forceinline__ void conv_loadu(const bf16* PROJ, size_t row, int ch, float (&u)[8]) {
    const v4u a = *(const v4u*)(PROJ + row * NP + C_CC + ch), b = *(const v4u*)(PROJ + row * NP + C_CX + ch);
    float fa[8], fb[8]; unpack8(a, fa); unpack8(b, fb);
#pragma unroll
    for (int i = 0; i < 8; ++i) u[i] = fa[i] * fb[i];
}
__device__ __forceinline__ void p2b_phase(Frame& F) {
    LAS float* L = (LAS float*)F.lds;
    const int tid = F.tid, c = tid & 127, ig = tid >> 7;
    for (int u = F.bx; u < 256; u += F.G) {
        const int g = u & 7, hh = (u >> 3) & 3, b = u >> 5;
        gla_load_gate(L, F, hh);
        __syncthreads();
        float hreg[16]; float dprod = 1.f;
        if (g == 0) {
#pragma unroll
            for (int dd = 0; dd < 16; ++dd) hreg[dd] = 0.f;
            gla_state_chunk(L, F, hh, true, 0, hreg, dprod);
        } else {
            const int u0 = u & ~7;
            { const f32x4* ap = (const f32x4*)(F.AGG + ((size_t)u0 * NTHR + tid) * 16);
#pragma unroll
                for (int q = 0; q < 4; ++q) { const f32x4 a4 = ap[q]; hreg[4 * q] = a4[0]; hreg[4 * q + 1] = a4[1]; hreg[4 * q + 2] = a4[2]; hreg[4 * q + 3] = a4[3]; } }
            for (int gp = 1; gp < g; ++gp) {
                const f32x4* ap = (const f32x4*)(F.AGG + ((size_t)(u0 + gp) * NTHR + tid) * 16); const f32x4* dp = (const f32x4*)(F.DG + (size_t)(u0 + gp) * 64 + 16 * ig);
#pragma unroll
                for (int q = 0; q < 4; ++q) { const f32x4 a4 = ap[q], d4 = dp[q];
#pragma unroll
                    for (int i = 0; i < 4; ++i) hreg[4 * q + i] = d4[i] * hreg[4 * q + i] + a4[i]; }
            }
        }
        LAS float* hp = opq(L + L_H + (16 * ig) * 128 + c); LAS float* obp = opq(L + L_KBT + (16 * ig) * 132 + c); const LAS float* ebp = opq(L + L_EBL + 16 * ig);
#pragma unroll
        for (int dd = 0; dd < 16; ++dd) hp[dd * 128] = hreg[dd];
        __syncthreads();
        for (int cc = 0; cc < 4; ++cc) {
            asm volatile("" ::: "memory");
            const size_t m0 = (size_t)b * SEQ + (size_t)(4 * g + cc) * 64;
            gla_stage_a<true>(L, F.PROJ, F.GR, hh, false, m0, tid);
            __syncthreads();
            {
                const int i = tid >> 3, jg = tid & 7; float acc[8];
#pragma unroll
                for (int jj = 0; jj < 8; ++jj) acc[jj] = 0.f;
#pragma unroll 4
                for (int d = 0; d < 64; ++d) { const float qv = L[L_QBT + d * LS + i];
#pragma unroll
                    for (int jj = 0; jj < 8; ++jj) acc[jj] += qv * L[L_KBT + d * LS + jg + 8 * jj]; }
#pragma unroll
                for (int jj = 0; jj < 8; ++jj) { const int j = jg + 8 * jj; L[L_AT + j * LS + i] = (j <= i) ? acc[jj] : 0.f; }
            }
            __syncthreads();
            float o[16];
#pragma unroll
            for (int ii = 0; ii < 16; ++ii) o[ii] = 0.f;
#pragma unroll 4
            for (int j = 0; j < 16 * (ig + 1); ++j) { const float vv = L[L_V + j * 128 + c]; const LAS f32x4* ap = (const LAS f32x4*)(L + L_AT + j * LS + 16 * ig);
#pragma unroll
                for (int q = 0; q < 4; ++q) { const f32x4 a4 = ap[q];
#pragma unroll
                    for (int i = 0; i < 4; ++i) o[4 * q + i] += a4[i] * vv; } }
#pragma unroll 4
            for (int d = 0; d < 64; ++d) { const float hv = L[L_H + d * 128 + c]; const LAS f32x4* qp = (const LAS f32x4*)(L + L_QBT + d * LS + 16 * ig);
#pragma unroll
                for (int q = 0; q < 4; ++q) { const f32x4 q4 = qp[q];
#pragma unroll
                    for (int i = 0; i < 4; ++i) o[4 * q + i] += q4[i] * hv; } }
            float dl[16]; gla_delta(L, c, ig, dl);
            __syncthreads();
#pragma unroll
            for (int dd = 0; dd < 16; ++dd) { hreg[dd] = ebp[dd] * hreg[dd] + dl[dd]; hp[dd * 128] = hreg[dd]; }
#pragma unroll
            for (int ii = 0; ii < 16; ++ii) obp[ii * 132] = o[ii];
            __syncthreads();
            {
                asm volatile("" ::: "memory");
                const int i = tid >> 3, part = tid & 7; const size_t row = m0 + i;
                const LAS f32x4* op = (const LAS f32x4*)(L + L_KBT + i * 132 + 16 * part);
                f32x4 ov[4]; float s = 0.f;
#pragma unroll
                for (int q = 0; q < 4; ++q) { ov[q] = op[q]; s += (ov[q][0] * ov[q][0] + ov[q][1] * ov[q][1]) + (ov[q][2] * ov[q][2] + ov[q][3] * ov[q][3]); }
                s += __shfl_xor(s, 1); s += __shfl_xor(s, 2); s += __shfl_xor(s, 4);
                const float rstd = 1.0f / sqrtf(s * (1.0f / 128.0f) + EPS);
                const v4u g0 = *(const v4u*)(F.PROJ + row * NP + C_G + hh * 128 + 16 * part), g1 = *(const v4u*)(F.PROJ + row * NP + C_G + hh * 128 + 16 * part + 8);
                float gf[16]; { float t0[8], t1[8]; unpack8(g0, t0); unpack8(g1, t1);
#pragma unroll
                    for (int e = 0; e < 8; ++e) { gf[e] = t0[e]; gf[8 + e] = t1[e]; } }
                float y[16];
#pragma unroll
                for (int q = 0; q < 4; ++q) { const f32x4 w4 = *(const f32x4*)(F.gnw + 16 * part + 4 * q);
#pragma unroll
                    for (int e = 0; e < 4; ++e) { const float gg = gf[4 * q + e]; y[4 * q + e] = ov[q][e] * rstd * w4[e] * (gg / (1.0f + __expf(-gg))); } }
                v4u w0, w1; w0.x = pk2(y[0], y[1]); w0.y = pk2(y[2], y[3]); w0.z = pk2(y[4], y[5]); w0.w = pk2(y[6], y[7]);
                w1.x = pk2(y[8], y[9]); w1.y = pk2(y[10], y[11]); w1.z = pk2(y[12], y[13]); w1.w = pk2(y[14], y[15]);
                *(v4u*)(F.MIX + row * D + hh * 128 + 16 * part) = w0; *(v4u*)(F.MIX + row * D + hh * 128 + 16 * part + 8) = w1;
            }
            __syncthreads();
        }
        {
            const int cgp = tid & 63, rs = tid >> 6, ch = 8 * cgp; const size_t ms = (size_t)64 * u + rs * 8;
            float w0[8], w1[8], w2[8];
#pragma unroll
            for (int q = 0; q < 2; ++q) { const f32x4 a = *(const f32x4*)(F.convw + ch + 4 * q), bb = *(const f32x4*)(F.convw + 512 + ch + 4 * q), cc4 = *(const f32x4*)(F.convw + 1024 + ch + 4 * q);
#pragma unroll
                for (int e = 0; e < 4; ++e) { w0[4 * q + e] = a[e]; w1[4 * q + e] = bb[e]; w2[4 * q + e] = cc4[e]; } }
            const bool first = (ms % SEQ) == 0;
            float u2[8], u1[8], u0[8];
            conv_loadu(F.PROJ, first ? (size_t)(M + 14) : ms - 2, ch, u2);
            conv_loadu(F.PROJ, first ? (size_t)(M + 15) : ms - 1, ch, u1);
#pragma unroll 2
            for (int r = 0; r < 8; ++r) { const size_t row = ms + r; conv_loadu(F.PROJ, row, ch, u0);
                const v4u cb8 = *(const v4u*)(F.PROJ + row * NP + C_CB + ch); float cb[8], y[8]; unpack8(cb8, cb);
#pragma unroll
                for (int e = 0; e < 8; ++e) { y[e] = cb[e] * (w0[e] * u2[e] + w1[e] * u1[e] + w2[e] * u0[e]); u2[e] = u1[e]; u1[e] = u0[e]; }
                v4u wv; wv.x = pk2(y[0], y[1]); wv.y = pk2(y[2], y[3]); wv.z = pk2(y[4], y[5]); wv.w = pk2(y[6], y[7]);
                *(v4u*)(F.MIX + row * D + 512 + ch) = wv; }
        }
    }
}

__global__ void __launch_bounds__(NTHR, 2) fwd(Args args) {
    extern __shared__ __attribute__((aligned(16))) unsigned char lds[];
    cg::grid_group grid = cg::this_grid();
    Frame F;
    F.lds = (LAS unsigned char*)lds; F.tid = threadIdx.x; F.lane = F.tid & 63; F.wave = __builtin_amdgcn_readfirstlane(F.tid >> 6); F.G = gridDim.x; F.bx = blockIdx.x;
    F.x = args.in[0]; F.meta = args.in[1]; F.nmix = args.in[2]; F.win = args.in[3]; F.wgu = args.in[4]; F.bgate = args.in[5]; F.gnw = args.in[6]; F.convw = args.in[7];
    F.wout = args.in[8]; F.nmlp = args.in[9]; F.wup = args.in[10]; F.wdn = args.in[11]; F.nfin = args.in[12]; F.out = args.out;
    unsigned char* ws = args.ws;
    F.WinT = (bf16*)(ws + WS_WIN); F.WoutT = (bf16*)(ws + WS_WOUT); F.WupT = (bf16*)(ws + WS_WUP); F.WdnT = (bf16*)(ws + WS_WDN);
    F.XN = (bf16*)(ws + WS_XN); F.PROJ = (bf16*)(ws + WS_PROJ); F.MIX = (bf16*)(ws + WS_MIX); F.HB = (bf16*)(ws + WS_HB);
    F.GR = (float*)(ws + WS_GR); F.AGG = (float*)(ws + WS_AGG); F.DG = (float*)(ws + WS_DG); F.SS1 = (float*)(ws + WS_SS1); F.SS2 = (float*)(ws + WS_SS2);
    const int lo = args.ph_lo, hi = args.ph_hi;
    if (F.tid < 16) ((volatile LAS unsigned*)(F.lds + MISC_OFF))[F.tid] = 0u;
    __syncthreads();
    XcdBarrier bar = xcd_barrier_post((unsigned*)(ws + WS_BAR), (volatile LAS unsigned*)(F.lds + MISC_OFF));
    if (hi == 99) grid.sync();
#define IN(k) (lo <= (k) && (k) < hi)
#define SEAM(k) do { if (IN(k) && IN((k) + 1)) xcd_barrier(bar); } while (0)
    if (IN(0) && !(SKIPMASK & 1)) { p0_prologue(F); if (REPMASK & 1) { xcd_barrier(bar); p0_prologue(F); } } SEAM(0);
    if (IN(1) && !(SKIPMASK & 2)) {
        pg8::Gemm g{F.XN, F.WinT, M, NP, D}; pg8::StaticOrder S; S.init(M, NP, F.G, F.bx);
        pg8::EpiBf16<0> E{F.PROJ, NP, nullptr, 0, 0, 1.0f};
        pg8::gemm_phase<pg8::EpiBf16<0>, pg8::StaticOrder, PG8_ALIGN, PG8_SP2>(F.lds, g, S, E);
    } SEAM(1);
    if (IN(2) && !(SKIPMASK & 4)) { p2a_phase(F); if (REPMASK & 4) { xcd_barrier(bar); p2a_phase(F); } } SEAM(2);
    if (IN(3) && !(SKIPMASK & 8)) { p2b_phase(F); if (REPMASK & 8) { xcd_barrier(bar); p2b_phase(F); } } SEAM(3);
    for (int es = 0; es < EXTRA_SYNCS; ++es) xcd_barrier(bar);
    if (IN(4) && !(SKIPMASK & 16)) {
        pg8::Gemm g{F.MIX, F.WoutT, M, D, D}; pg8::StaticOrder S; S.init(M, D, F.G, F.bx);
        EpiRes<true> E{F.x, F.out, F.XN, F.SS1};
        pg8::gemm_phase<EpiRes<true>, pg8::StaticOrder, false, PG8_SP2>(F.lds, g, S, E);
    } SEAM(4);
    if (IN(5) && !(SKIPMASK & 32)) {
        pg8::Gemm g{F.XN, F.WupT, M, FF, D}; pg8::StaticOrder S; S.init(M, FF, F.G, F.bx);
        EpiUp E{F.HB, FF, F.SS1};
        pg8::gemm_phase<EpiUp, pg8::StaticOrder, PG8_ALIGN, PG8_SP2>(F.lds, g, S, E);
    } SEAM(5);
    if (IN(6) && !(SKIPMASK & 64)) {
        pg8::Gemm g{F.HB, F.WdnT, M, D, FF}; pg8::StaticOrder S; S.init(M, D, F.G, F.bx);
        EpiRes<false> E{F.out, F.out, nullptr, F.SS2};
        pg8::gemm_phase<EpiRes<false>, pg8::StaticOrder, false, PG8_SP2>(F.lds, g, S, E);
    } SEAM(6);
    if (IN(7) && !(SKIPMASK & 128)) {
        const int gw = F.bx * NWAVES + F.wave, NGW = F.G * NWAVES; const f32x4* nw = (const f32x4*)F.nfin + F.lane;
        f32x4 nw4[4];
#pragma unroll
        for (int j = 0; j < 4; ++j) nw4[j] = nw[64 * j];
        for (int m = gw; m < M; m += NGW) {
            f32x4* xr = (f32x4*)(F.out + (size_t)m * D) + F.lane; const f32x4 s4 = *(const f32x4*)(F.SS2 + (size_t)m * 4);
            const float rstd = 1.0f / sqrtf(((s4[0] + s4[1]) + (s4[2] + s4[3])) * (1.0f / D) + EPS);
#pragma unroll
            for (int j = 0; j < 4; ++j) { const f32x4 v = xr[64 * j]; xr[64 * j] = v * rstd * nw4[j]; }
        }
    }
#undef IN
#undef SEAM
}

extern "C" void kernel_launch(void* const* d_in, const int* in_sizes, int n_in, void* d_out, int out_size, void* d_ws, size_t ws_size, hipStream_t stream) {
    static int grid = 0;
    if (grid == 0) {
        if (n_in != 13 || out_size != M * D || ws_size < 200 * MiB) { fprintf(stderr, "kernel_launch: unexpected problem shape\n"); grid = -1; return; }
        if (hipFuncSetAttribute((const void*)fwd, hipFuncAttributeMaxDynamicSharedMemorySize, LDS_BYTES) != hipSuccess) { fprintf(stderr, "kernel_launch: hipFuncSetAttribute failed\n"); grid = -1; return; }
        grid = 256;
    }
    if (grid < 0) return;
    Args a{};
    for (int i = 0; i < 13; ++i) a.in[i] = (const float*)d_in[i];
    a.out = (float*)d_out; a.ws = (unsigned char*)d_ws;
    if (hipMemsetAsync((char*)d_ws + WS_BAR, 0, BAR_BYTES, stream) != hipSuccess) { fprintf(stderr, "kernel_launch: memset of the barrier words failed\n"); return; }
#if ONE_LAUNCH
    a.ph_lo = 0; a.ph_hi = 8;
    void* kargs[] = {&a};
    hipError_t e = hipLaunchCooperativeKernel((void*)fwd, dim3(grid), dim3(NTHR), kargs, LDS_BYTES, stream);
    if (e != hipSuccess) fprintf(stderr, "cooperative launch failed: %s (grid %d)\n", hipGetErrorString(e), grid);
#else
    for (int p = 0; p < 8; ++p) { a.ph_lo = p; a.ph_hi = p + 1; hipLaunchKernelGGL(fwd, dim3(grid), dim3(NTHR), LDS_BYTES, stream, a); }
#endif
}
```

```cpp
#include <hip/hip_runtime.h>
#include <hip/hip_cooperative_groups.h>
#include <cstdio>
#include <cstdint>
#include <cmath>
namespace cg = cooperative_groups;
namespace pg8 {
#define PG8_LAS __attribute__((address_space(3)))
typedef unsigned short bf16_t;
typedef short bf16x8 __attribute__((ext_vector_type(8)));
typedef float f32x4 __attribute__((ext_vector_type(4)));
typedef unsigned u32x4 __attribute__((ext_vector_type(4)));
constexpr int BM = 256, BK = 64, HALF = 128, HTB = HALF * BK * 2  , STAGE_BYTES = 8 * HTB, NXCD = 8, WGM = 8;

__host__ __device__ __forceinline__ int lds_byte(int r, int c) { const int st = (r >> 4) * 2 + (c >> 5), rr = r & 15, cc = c & 31, ob = rr * 64 + cc * 2; return st * 1024 + (ob ^ (((ob >> 9) & 1) << 5)); }
__host__ __device__ __forceinline__ void stage_rc(int b, int& R, int& C) { const int st = b / 1024, sb = b % 1024, swz = sb ^ (((sb >> 9) & 1) << 5); R = (st >> 1) * 16 + swz / 64; C = (st & 1) * 32 + (swz % 64) / 2; }
__host__ __device__ __forceinline__ int perm32(int rho) { const int n = rho >> 4, i = rho & 15; return 8 * (i >> 2) + 4 * n + (i & 3); }

struct Unit { int pm, pn; };
struct Gemm { const bf16_t* A; const bf16_t* Bt; int M, N, K; };

struct StaticOrder {
    int nM, nN, nwg, G, c;
    __host__ __device__ void init(int M, int N, int G_, int c_) { nM = M / BM; nN = N / BM; nwg = nM * nN; G = G_; c = c_; }
    __host__ __device__ bool next(int i, Unit& u) const {
        const long L = (long)i * G + c; if (L >= nwg) return false;
        int wgid = (int)L; { const int q = nwg / NXCD, r = nwg % NXCD, xcd = wgid % NXCD, off = wgid / NXCD; wgid = (xcd < r ? xcd * (q + 1) : r * (q + 1) + (xcd - r) * q) + off; }
        const int nig = WGM * nN, gid = wgid / nig, fm = gid * WGM, gsz = (nM - fm) < WGM ? (nM - fm) : WGM;
        u.pm = fm + ((wgid % nig) % gsz); u.pn = (wgid % nig) / gsz; return true;
    }
    __device__ __forceinline__ void a_ready(const Unit&) const {}
    __device__ __forceinline__ void done(const Unit&) const {}
};

__device__ __forceinline__ unsigned cvt_pk_bf16(float lo, float hi) { unsigned r; asm volatile("v_cvt_pk_bf16_f32 %0, %1, %2" : "=v"(r) : "v"(lo), "v"(hi)); return r; }
typedef float f32x2 __attribute__((ext_vector_type(2)));
__device__ __forceinline__ f32x2 gelu_pk(f32x2 v) {
    const f32x2 av = __builtin_elementwise_abs(v), d = av * 0.2316418882f + 1.0f;
    f32x2 t; t.x = __builtin_amdgcn_rcpf(d.x); t.y = __builtin_amdgcn_rcpf(d.y);
    f32x2 q = t * 0.5307027145f + (-0.7265760135f); q = q * t + 0.7107068705f; q = q * t + (-0.142248368f); q = q * t + 0.127414796f; q = q * t;
    const f32x2 s = (v * v) * (-0.72134752044f);
    f32x2 e; e.x = __builtin_amdgcn_exp2f(s.x); e.y = __builtin_amdgcn_exp2f(s.y);
    const f32x2 m = v * (q * e), r = v - m;
    f32x2 o; o.x = v.x < 0.f ? m.x : r.x; o.y = v.y < 0.f ? m.y : r.y; return o;
}

template <int ACT  > struct EpiBf16 {
    static constexpr bool PERM = true, AFTER_DRAIN = false; static_assert(ACT == 0 || ACT == 1, "EpiBf16: ACT is 0 (none) or 1 (gelu_pk)");
    bf16_t* O; int ldc; const float* bias; int split_cols; size_t split_stride; float scale0;
    __device__ __forceinline__ void operator()(const f32x4 (&acc)[2][2][4][2], const Unit& u, int wr, int wc, int fr, int fq) const {
        const int row0 = u.pm * BM + wr * 64 + fr; int colt = u.pn * BM; bf16_t* base = O;
        float sc = 1.f; if (split_cols) { const int t = colt / split_cols; base += (size_t)t * split_stride; colt -= t * split_cols; if (t == 0) sc = scale0; }
        const int col0 = colt + wc * 32 + 8 * fq, bcol0 = u.pn * BM + wc * 32 + 8 * fq;
        f32x4 bv[2][2];
#pragma unroll
        for (int bj = 0; bj < 2; ++bj)
#pragma unroll
            for (int n = 0; n < 2; ++n) bv[bj][n] = bias ? *(const f32x4*)(bias + bcol0 + bj * HALF + 4 * n) : (f32x4){0.f, 0.f, 0.f, 0.f};
#pragma unroll
        for (int ai = 0; ai < 2; ++ai)
#pragma unroll
            for (int m = 0; m < 4; ++m) { bf16_t* rowp = base + (size_t)(row0 + ai * HALF + m * 16) * ldc + col0;
#pragma unroll
                for (int bj = 0; bj < 2; ++bj) { f32x4 v0 = acc[ai][bj][m][0] + bv[bj][0], v1 = acc[ai][bj][m][1] + bv[bj][1];
                    if (ACT == 1) { f32x2 a = gelu_pk((f32x2){v0[0], v0[1]}), b = gelu_pk((f32x2){v0[2], v0[3]}), c = gelu_pk((f32x2){v1[0], v1[1]}), d = gelu_pk((f32x2){v1[2], v1[3]});
                        v0 = (f32x4){a.x, a.y, b.x, b.y}; v1 = (f32x4){c.x, c.y, d.x, d.y}; }
                    v0 = v0 * sc; v1 = v1 * sc; u32x4 w; w.x = cvt_pk_bf16(v0[0], v0[1]); w.y = cvt_pk_bf16(v0[2], v0[3]); w.z = cvt_pk_bf16(v1[0], v1[1]); w.w = cvt_pk_bf16(v1[2], v1[3]);
                    *(u32x4*)(rowp + bj * HALF) = w; } }
    }
};

template <class Epi, class Sched, bool ALIGN_EPI = false, bool SP2 = false>
__device__ __forceinline__ void gemm_phase(PG8_LAS unsigned char* lds, const Gemm g, const Sched& S, const Epi& E) {
    const int tid = threadIdx.x, wid = __builtin_amdgcn_readfirstlane(tid >> 6), lane = tid & 63, wr = wid >> 2, wc = wid & 3, fr = lane & 15, fq = lane >> 4;
    const int K = g.K, nt = K / BK;
    unsigned voffA[2], voffB[2];
#pragma unroll
    for (int i = 0; i < 2; ++i) { int R, C; stage_rc(tid * 16 + i * 8192, R, C); const int Rb = Epi::PERM ? ((R & ~31) + perm32(R & 31)) : R;
        voffA[i] = (unsigned)(R * K + C) * 2u; voffB[i] = (unsigned)(Rb * K + C) * 2u; }
    const size_t kstep = (size_t)(BK * 2);
    const size_t hstep = (size_t)HALF * K * 2;
    const size_t tstep = 2 * hstep;
    const unsigned ldsw = (unsigned)wid * 1024u;
    const int aoff = lds_byte(wr * 64 + fr, fq * 8), boff = lds_byte(wc * 32 + fr, fq * 8);
#define PG8_SA(b, h) (((b) * 2 + (h)) * HTB)
#define PG8_SB(b, h) ((4 + (b) * 2 + (h)) * HTB)
#define PG8_STAGE(bufoff, gbase, voff) do { _Pragma("unroll") for (int _i = 0; _i < 2; ++_i) \
        __builtin_amdgcn_global_load_lds((const unsigned*)((const char*)(gbase) + (voff)[_i]), (PG8_LAS unsigned*)(lds + (bufoff) + ldsw + _i * 8192), 16, 0, 0); } while (0)
#define PG8_LDA(dst, b, h) do { _Pragma("unroll") for (int m = 0; m < 4; ++m) _Pragma("unroll") for (int k = 0; k < 2; ++k) dst[m][k] = *(const PG8_LAS bf16x8*)(lds + PG8_SA(b, h) + aoff + m * 2048 + k * 1024); } while (0)
#define PG8_LDB(dst, b, h) do { _Pragma("unroll") for (int n = 0; n < 2; ++n) _Pragma("unroll") for (int k = 0; k < 2; ++k) dst[n][k] = *(const PG8_LAS bf16x8*)(lds + PG8_SB(b, h) + boff + n * 2048 + k * 1024); } while (0)
#define PG8_MMA(ai, bj, At, Bt) do { __builtin_amdgcn_s_setprio(1); _Pragma("unroll") for (int m = 0; m < 4; ++m) _Pragma("unroll") for (int n = 0; n < 2; ++n) _Pragma("unroll") for (int k = 0; k < 2; ++k) \
        acc[ai][bj][m][n] = __builtin_amdgcn_mfma_f32_16x16x32_bf16(Bt[n][k], At[m][k], acc[ai][bj][m][n], 0, 0, 0); __builtin_amdgcn_s_setprio(0); } while (0)
#define PG8_WAIT_V(n) asm volatile("s_waitcnt vmcnt(" #n ")" ::: "memory")
#define PG8_WAIT_L(n) asm volatile("s_waitcnt lgkmcnt(" #n ")" ::: "memory")
#define PG8_BAR __builtin_amdgcn_s_barrier()
#define PG8_SCHED __builtin_amdgcn_sched_barrier(0)
    Unit cur, nxt; int ui = 0;
    if (!S.next(0, cur)) return;
    f32x4 acc[2][2][4][2];
#pragma unroll
    for (int a = 0; a < 2; ++a)
#pragma unroll
        for (int b = 0; b < 2; ++b)
#pragma unroll
            for (int m = 0; m < 4; ++m)
#pragma unroll
                for (int n = 0; n < 2; ++n) acc[a][b][m][n] = (f32x4){0.f, 0.f, 0.f, 0.f};
    bf16x8 At[4][2], B0[2][2], B1[2][2];
    const char* cA = (const char*)g.A + (size_t)cur.pm * tstep; const char* cB = (const char*)g.Bt + (size_t)cur.pn * tstep;
    S.a_ready(cur);
    if constexpr (SP2) {
        PG8_STAGE(PG8_SB(0, 0), cB, voffB); PG8_STAGE(PG8_SB(0, 1), cB + hstep, voffB); PG8_STAGE(PG8_SA(0, 0), cA, voffA); PG8_STAGE(PG8_SA(0, 1), cA + hstep, voffA);
        if (wr == 1) PG8_BAR;
        PG8_WAIT_V(2); PG8_BAR;
        PG8_STAGE(PG8_SB(1, 0), cB + kstep, voffB); PG8_STAGE(PG8_SA(1, 0), cA + kstep, voffA); PG8_STAGE(PG8_SB(1, 1), cB + hstep + kstep, voffB);
        PG8_WAIT_V(6); PG8_BAR;
    } else {
        PG8_STAGE(PG8_SB(0, 0), cB, voffB); PG8_STAGE(PG8_SA(0, 0), cA, voffA); PG8_STAGE(PG8_SB(0, 1), cB + hstep, voffB); PG8_STAGE(PG8_SA(0, 1), cA + hstep, voffA);
        if (wr == 1) PG8_BAR;
        PG8_WAIT_V(4); PG8_BAR;
        PG8_STAGE(PG8_SB(1, 0), cB + kstep, voffB); PG8_STAGE(PG8_SA(1, 0), cA + kstep, voffA); PG8_STAGE(PG8_SB(1, 1), cB + hstep + kstep, voffB);
        PG8_WAIT_V(6); PG8_BAR;
    }
    for (;;) {
        const bool has_next = S.next(ui + 1, nxt);
        const char* nA = has_next ? (const char*)g.A + (size_t)nxt.pm * tstep : cA; const char* nB = has_next ? (const char*)g.Bt + (size_t)nxt.pn * tstep : cB;
        for (int t = 0; t < nt; t += 2) {
            const bool last = (t == nt - 2);
            const char* a1 = cA + (size_t)(t + 1) * kstep;
            const char* a2 = last ? nA : cA + (size_t)(t + 2) * kstep; const char* b2 = last ? nB : cB + (size_t)(t + 2) * kstep;
            const char* a3 = a2 + kstep; const char* b3 = b2 + kstep;
            if (last && has_next) S.a_ready(nxt);
            if constexpr (SP2) {
            PG8_LDB(B0, 0, 0); PG8_LDB(B1, 0, 1); PG8_SCHED; PG8_LDA(At, 0, 0); PG8_STAGE(PG8_SA(1, 1), a1 + hstep, voffA);
            PG8_WAIT_V(8); PG8_WAIT_L(0); PG8_BAR; PG8_MMA(0, 0, At, B0); PG8_MMA(0, 1, At, B1); PG8_BAR; PG8_SCHED;
            PG8_LDA(At, 0, 1); PG8_STAGE(PG8_SB(0, 0), b2, voffB); PG8_STAGE(PG8_SB(0, 1), b2 + hstep, voffB); PG8_STAGE(PG8_SA(0, 0), a2, voffA);
            PG8_WAIT_V(8); PG8_WAIT_L(0); PG8_BAR; PG8_MMA(1, 0, At, B0); PG8_MMA(1, 1, At, B1); PG8_BAR; PG8_SCHED;
            PG8_LDB(B0, 1, 0); PG8_LDB(B1, 1, 1); PG8_SCHED; PG8_LDA(At, 1, 0); PG8_STAGE(PG8_SA(0, 1), a2 + hstep, voffA);
            PG8_WAIT_V(8); PG8_WAIT_L(0); PG8_BAR; PG8_MMA(0, 0, At, B0); PG8_MMA(0, 1, At, B1); PG8_BAR; PG8_SCHED;
            PG8_LDA(At, 1, 1); PG8_STAGE(PG8_SB(1, 0), b3, voffB); PG8_STAGE(PG8_SB(1, 1), b3 + hstep, voffB); PG8_STAGE(PG8_SA(1, 0), a3, voffA);
            PG8_WAIT_V(8); PG8_WAIT_L(0); PG8_BAR; PG8_MMA(1, 0, At, B0); PG8_MMA(1, 1, At, B1); PG8_BAR; PG8_SCHED;
            } else {
            PG8_LDB(B0, 0, 0); PG8_SCHED; PG8_LDA(At, 0, 0); PG8_STAGE(PG8_SA(1, 1), a1 + hstep, voffA);
            PG8_WAIT_L(8); PG8_BAR; PG8_WAIT_L(0); PG8_MMA(0, 0, At, B0); PG8_BAR; PG8_SCHED;
            PG8_LDB(B1, 0, 1); PG8_STAGE(PG8_SB(0, 0), b2, voffB);
            PG8_BAR; PG8_WAIT_L(0); PG8_MMA(0, 1, At, B1); PG8_BAR;
            PG8_LDA(At, 0, 1); PG8_STAGE(PG8_SA(0, 0), a2, voffA);
            PG8_BAR; PG8_WAIT_L(0); PG8_MMA(1, 0, At, B0); PG8_BAR; PG8_SCHED;
            PG8_STAGE(PG8_SB(0, 1), b2 + hstep, voffB);
            PG8_WAIT_V(6); PG8_BAR; PG8_MMA(1, 1, At, B1); PG8_BAR;
            PG8_LDB(B0, 1, 0); PG8_SCHED; PG8_LDA(At, 1, 0); PG8_STAGE(PG8_SA(0, 1), a2 + hstep, voffA);
            PG8_WAIT_L(8); PG8_BAR; PG8_WAIT_L(0); PG8_MMA(0, 0, At, B0); PG8_BAR; PG8_SCHED;
            PG8_LDB(B1, 1, 1); PG8_STAGE(PG8_SB(1, 0), b3, voffB);
            PG8_BAR; PG8_WAIT_L(0); PG8_MMA(0, 1, At, B1); PG8_BAR;
            PG8_LDA(At, 1, 1); PG8_STAGE(PG8_SA(1, 0), a3, voffA);
            PG8_BAR; PG8_WAIT_L(0); PG8_MMA(1, 0, At, B0); PG8_BAR; PG8_SCHED;
            PG8_STAGE(PG8_SB(1, 1), b3 + hstep, voffB);
            PG8_WAIT_V(6); PG8_BAR; PG8_MMA(1, 1, At, B1); PG8_BAR;
            }
        }
        if constexpr (ALIGN_EPI) { if (wr == 0) PG8_BAR; }
        if constexpr (!Epi::AFTER_DRAIN) { E(acc, cur, wr, wc, fr, fq); S.done(cur); }
        if (!has_next) break;
#pragma unroll
        for (int a = 0; a < 2; ++a)
#pragma unroll
            for (int b = 0; b < 2; ++b)
#pragma unroll
                for (int m = 0; m < 4; ++m)
#pragma unroll
                    for (int n = 0; n < 2; ++n) acc[a][b][m][n] = (f32x4){0.f, 0.f, 0.f, 0.f};
        cur = nxt; cA = nA; cB = nB; ++ui;
        if constexpr (ALIGN_EPI) { if (wr == 1) PG8_BAR; }
    }
    PG8_WAIT_V(0);
    if constexpr (!ALIGN_EPI) { if (wr == 0) PG8_BAR; }
    PG8_BAR;
    if constexpr (Epi::AFTER_DRAIN) { E.fused(acc, cur, wr, wc, fr, fq, lds, wid, lane); S.done(cur); }
#undef PG8_SA
#undef PG8_SB
#undef PG8_STAGE
#undef PG8_LDA
#undef PG8_LDB
#undef PG8_MMA
#undef PG8_WAIT_V
#undef PG8_WAIT_L
#undef PG8_BAR
#undef PG8_SCHED
}
}

#ifndef PG8_SP2
#define PG8_SP2 true
#endif
#ifndef PG8_ALIGN
#define PG8_ALIGN true
#endif
#ifndef SKIPMASK
#define SKIPMASK 0
#endif
#ifndef REPMASK
#define REPMASK 0
#endif
#ifndef EXTRA_SYNCS
#define EXTRA_SYNCS 0
#endif
#ifndef ONE_LAUNCH
#define ONE_LAUNCH 1
#endif
constexpr int NB = 8, SEQ = 2048, D = 1024, FF = 4096, M = NB * SEQ;
constexpr int NMETA = 16, MR = M + NMETA;
constexpr int PW = 3088, NP = 3072;
constexpr int C_Q = 0, C_K = 256, C_V = 512, C_G = 1024, C_CB = 1536, C_CC = 2048, C_CX = 2560;
constexpr int SRC_GR = 1536;
constexpr float EPS = 1e-6f;
constexpr size_t MiB = 1u << 20;
constexpr size_t WS_SS1 = 0, WS_SS2 = 256 * 1024;
constexpr size_t WS_WIN = 1 * MiB, WS_WOUT = 7 * MiB, WS_WUP = 9 * MiB, WS_WDN = 17 * MiB;
constexpr size_t WS_GR = 25 * MiB;
constexpr size_t WS_AGG = 27 * MiB, WS_DG = 35 * MiB;
constexpr size_t WS_XN = 36 * MiB;
constexpr size_t WS_PROJ = 68 * MiB;
constexpr size_t WS_MIX = 166 * MiB;
constexpr size_t WS_HB = 68 * MiB;
constexpr size_t WS_BAR = 512 * 1024, BAR_BYTES = 16384;
constexpr int LDS_BYTES = 147456, MISC_OFF = LDS_BYTES - 64;
constexpr int NWAVES = 8, NTHR = 512;

#define LAS __attribute__((address_space(3)))
typedef unsigned short bf16;
typedef unsigned v4u __attribute__((ext_vector_type(4)));
typedef unsigned v2u __attribute__((ext_vector_type(2)));
typedef float f32x4 __attribute__((ext_vector_type(4)));
#define LDS_WAIT() asm volatile("s_waitcnt lgkmcnt(0)" ::: "memory")
__device__ __forceinline__ unsigned f2bf(float f) { unsigned u = __builtin_bit_cast(unsigned, f); return (u + 0x7fffu + ((u >> 16) & 1u)) >> 16; }
__device__ __forceinline__ unsigned pk2(float lo, float hi) { return f2bf(lo) | (f2bf(hi) << 16); }
__device__ __forceinline__ float bflo(unsigned u) { return __builtin_bit_cast(float, u << 16); }
__device__ __forceinline__ float bfhi(unsigned u) { return __builtin_bit_cast(float, u & 0xffff0000u); }
__device__ __forceinline__ void unpack8(v4u p, float (&o)[8]) { o[0] = bflo(p.x); o[1] = bfhi(p.x); o[2] = bflo(p.y); o[3] = bfhi(p.y); o[4] = bflo(p.z); o[5] = bfhi(p.z); o[6] = bflo(p.w); o[7] = bfhi(p.w); }
__device__ __forceinline__ float wave_sum(float v) {
#pragma unroll
    for (int o = 1; o < 64; o <<= 1) v += __shfl_xor(v, o);
    return v;
}

template <bool WB> struct EpiRes {
    static constexpr bool PERM = false, AFTER_DRAIN = true;
    const float* base; float* out; pg8::bf16_t* hb; float* ss;
    __device__ __forceinline__ void fused(pg8::f32x4 (&acc)[2][2][4][2], const pg8::Unit& u, int wr, int wc, int fr, int fq, LAS unsigned char* lds, int wid, int lane) const {
        LAS float* P = (LAS float*)lds;
        const int col0 = u.pn * 256 + wc * 32 + 4 * fq;
#pragma unroll
        for (int ai = 0; ai < 2; ++ai)
#pragma unroll
            for (int m = 0; m < 4; ++m) {
                const int r = ai * 128 + wr * 64 + m * 16 + fr; const size_t off = (size_t)(u.pm * 256 + r) * D + col0; float s = 0.f;
#pragma unroll
                for (int bj = 0; bj < 2; ++bj)
#pragma unroll
                    for (int n = 0; n < 2; ++n) {
                        const f32x4 bs = *(const f32x4*)(base + off + bj * 128 + n * 16); const f32x4 v = acc[ai][bj][m][n] + bs;
                        *(f32x4*)(out + off + bj * 128 + n * 16) = v; s += (v[0] * v[0] + v[1] * v[1]) + (v[2] * v[2] + v[3] * v[3]);
                        if (WB) { v2u w; w.x = pk2(v[0], v[1]); w.y = pk2(v[2], v[3]); *(v2u*)(hb + off + bj * 128 + n * 16) = w; }
                    }
                s += __shfl_xor(s, 16); s += __shfl_xor(s, 32);
                if (fq == 0) P[r * 4 + wc] = s;
                if (m & 1) asm volatile("" ::: "memory");
            }
        __syncthreads();
        const int tid = wid * 64 + lane;
        if (tid < 256) { const f32x4 p = *(const LAS f32x4*)(P + tid * 4); ss[(size_t)(u.pm * 256 + tid) * 4 + u.pn] = (p[0] + p[1]) + (p[2] + p[3]); }
    }
};
struct EpiUp {
    static constexpr bool PERM = true, AFTER_DRAIN = false;
    pg8::bf16_t* O; int ldc; const float* ss;
    __device__ __forceinline__ void operator()(const pg8::f32x4 (&acc)[2][2][4][2], const pg8::Unit& u, int wr, int wc, int fr, int fq) const {
        const int row0 = u.pm * 256 + wr * 64 + fr, col0 = u.pn * 256 + wc * 32 + 8 * fq;
#pragma unroll
        for (int ai = 0; ai < 2; ++ai)
#pragma unroll
            for (int m = 0; m < 4; ++m) {
                const int row = row0 + ai * 128 + m * 16; const f32x4 s4 = *(const f32x4*)(ss + (size_t)row * 4);
                const float rstd = __builtin_amdgcn_rsqf(((s4[0] + s4[1]) + (s4[2] + s4[3])) * (1.0f / D) + EPS);
                pg8::bf16_t* rowp = O + (size_t)row * ldc + col0;
#pragma unroll
                for (int bj = 0; bj < 2; ++bj) {
                    f32x4 v0 = acc[ai][bj][m][0] * rstd, v1 = acc[ai][bj][m][1] * rstd;
#pragma unroll
                    for (int e = 0; e < 4; ++e) { const float a = fmaxf(v0[e], 0.f), b = fmaxf(v1[e], 0.f); v0[e] = a * a; v1[e] = b * b; }
                    v4u w; w.x = pg8::cvt_pk_bf16(v0[0], v0[1]); w.y = pg8::cvt_pk_bf16(v0[2], v0[3]); w.z = pg8::cvt_pk_bf16(v1[0], v1[1]); w.w = pg8::cvt_pk_bf16(v1[2], v1[3]);
                    *(v4u*)(rowp + bj * 128) = w;
                }
            }
    }
};

#define RLX_AGENT __ATOMIC_RELAXED, __HIP_MEMORY_SCOPE_AGENT
#define XB_TMO      128
#define XB_XCNT(j)  (256  + 64 * (j))
#define XB_XSUB(j)  (1280 + 64 * (j))
#define XB_XGEN(j)  (2304 + 64 * (j))
#define XB_TOP      3328
#define XB_TOPGEN   3392
#define XCD_BAR_WORDS 3456
#define XB_SPIN_CAP (1u << 18)

__device__ __forceinline__ unsigned xb_ld(unsigned* p)              { return __hip_atomic_load(p, __ATOMIC_RELAXED, __HIP_MEMORY_SCOPE_AGENT); }
__device__ __forceinline__ unsigned xb_add(unsigned* p, unsigned v) { return __hip_atomic_fetch_add(p, v, __ATOMIC_RELAXED, __HIP_MEMORY_SCOPE_AGENT); }
__device__ __forceinline__ unsigned xb_xcc_id() { return (unsigned)__builtin_amdgcn_s_getreg((3 << 11) | 20) & 0xFu; }
#define XB_SPIN(cond, bar) do { unsigned _sp = 0; while (cond) { __builtin_amdgcn_s_sleep(1); \
    if ((++_sp & 255u) == 0u) { if (xb_ld(&(bar)[XB_TMO])) break; if (_sp > XB_SPIN_CAP) { atomicAdd(&(bar)[XB_TMO], 1u); break; } } } } while (0)

struct XcdBarrier {
    unsigned* bar; unsigned x;
    volatile LAS unsigned* st;
};

__device__ __forceinline__ XcdBarrier xcd_barrier_post(unsigned* bar, volatile LAS unsigned* st) {
    XcdBarrier b; b.bar = bar; b.x = xb_xcc_id(); b.st = st;
    if (threadIdx.x == 0) (void)xb_add(&bar[XB_XCNT(b.x)], 1u);
    return b;
}
__device__ __forceinline__ void xcd_barrier_complete(unsigned* bar, unsigned x, unsigned& nloc, unsigned& nx) {
    const unsigned G = gridDim.x * gridDim.y * gridDim.z;
    unsigned sum, cnt, mine, sp = 0u;
    for (;;) {
        sum = 0u; cnt = 0u; mine = 0u;
#pragma unroll
        for (unsigned j = 0; j < 16; ++j) { const unsigned c = xb_ld(&bar[XB_XCNT(j)]); sum += c; cnt += (c > 0u) ? 1u : 0u; mine = (j == x) ? c : mine; }
        if (sum == G) break;
        __builtin_amdgcn_s_sleep(1);
        if ((++sp & 255u) == 0u) { if (xb_ld(&bar[XB_TMO])) break; if (sp > XB_SPIN_CAP) { atomicAdd(&bar[XB_TMO], 1u); break; } }
    }
    nloc = mine > 0u ? mine : 1u; nx = cnt > 0u ? cnt : 1u;
}

__device__ __forceinline__ void xcd_barrier(const XcdBarrier& b) {
    asm volatile("s_waitcnt vmcnt(0)" ::: "memory");
    __syncthreads();
    if (threadIdx.x == 0) {
        unsigned* bar = b.bar;
        __builtin_amdgcn_s_waitcnt(0);
        unsigned nloc = b.st[0], nx = b.st[1];
        if (nloc == 0u) { xcd_barrier_complete(bar, b.x, nloc, nx); b.st[0] = nloc; b.st[1] = nx; }
        const unsigned old = xb_add(&bar[XB_XSUB(b.x)], 1u);
        const unsigned gen = old / nloc;
        if (old + 1u == (gen + 1u) * nloc) {
            __builtin_amdgcn_fence(__ATOMIC_RELEASE, "agent");
            asm volatile("s_waitcnt vmcnt(0)" ::: "memory");
            const unsigned og = xb_add(&bar[XB_TOP], 1u);
            const unsigned tg = og / nx;
            if (og + 1u == (tg + 1u) * nx) xb_add(&bar[XB_TOPGEN], 1u);
            else XB_SPIN(xb_ld(&bar[XB_TOPGEN]) == tg, bar);
            __builtin_amdgcn_fence(__ATOMIC_ACQUIRE, "agent");
            xb_add(&bar[XB_XGEN(b.x)], 1u);
            asm volatile("s_waitcnt vmcnt(0)" ::: "memory");
        } else {
            XB_SPIN(xb_ld(&bar[XB_XGEN(b.x)]) == gen, bar);
            __builtin_amdgcn_fence(__ATOMIC_ACQUIRE, "agent");
            asm volatile("s_waitcnt vmcnt(0)" ::: "memory");
        }
    }
    __syncthreads();
}

struct Args { const float* in[13]; float* out; unsigned char* ws; int ph_lo, ph_hi; };
struct Frame {
    LAS unsigned char* lds; int tid, lane, wave, G, bx;
    const float *x, *meta, *nmix, *win, *wgu, *bgate, *gnw, *convw, *wout, *nmlp, *wup, *wdn, *nfin; float* out;
    bf16 *WinT, *WoutT, *WupT, *WdnT, *XN, *PROJ, *MIX, *HB; float *GR, *AGG, *DG, *SS1, *SS2;
};

__device__ __forceinline__ void p0_transpose_item(const float* W, int ldw, int K, bf16* WT, int n0, int sc0, int k0, const float* kscale, float cscale, LAS float* scr, int lane) {
#pragma unroll 8
    for (int i = 0; i < 32; ++i) { const int kk = 2 * i + (lane >> 5); float s = cscale; if (kscale) s *= kscale[k0 + kk]; scr[kk * 33 + (lane & 31)] = W[(size_t)(k0 + kk) * ldw + sc0 + (lane & 31)] * s; }
    LDS_WAIT(); asm volatile("" ::: "memory");
    const int c = lane & 7;
#pragma unroll
    for (int j = 0; j < 4; ++j) { const int n = (lane >> 3) + 8 * j; const LAS float* s = scr + (8 * c) * 33 + n;
        v4u o; o.x = pk2(s[0 * 33], s[1 * 33]); o.y = pk2(s[2 * 33], s[3 * 33]); o.z = pk2(s[4 * 33], s[5 * 33]); o.w = pk2(s[6 * 33], s[7 * 33]);
        *(v4u*)(WT + (size_t)(n0 + n) * K + k0 + 8 * c) = o; }
    LDS_WAIT(); asm volatile("" ::: "memory");
}
__device__ __forceinline__ void p0_prologue(Frame& F) {
    const int tid = F.tid, lane = F.lane, wave = F.wave;
    if (F.bx < 28) {
        LAS float* xm = (LAS float*)F.lds;
        LAS float* red = xm + 16384;
#pragma unroll
        for (int rr = 0; rr < 2; ++rr) {
            const int r = 2 * wave + rr; const f32x4* xr = (const f32x4*)(F.meta + (size_t)r * D) + lane; const f32x4* nw = (const f32x4*)F.nmix + lane;
            f32x4 v[4]; float s = 0.f;
#pragma unroll
            for (int j = 0; j < 4; ++j) { v[j] = xr[64 * j]; s += (v[j][0] * v[j][0] + v[j][1] * v[j][1]) + (v[j][2] * v[j][2] + v[j][3] * v[j][3]); }
            const float rstd = 1.0f / sqrtf(wave_sum(s) * (1.0f / D) + EPS);
#pragma unroll
            for (int j = 0; j < 4; ++j) { const f32x4 w4 = nw[64 * j];
#pragma unroll
                for (int i = 0; i < 4; ++i) xm[(256 * j + 4 * lane + i) * 16 + r] = v[j][i] * rstd * w4[i]; }
        }
        __syncthreads();
        {
            const int j = F.bx * 64 + lane; const int pc = j < 768 ? 256 + j : 2048 + (j - 768); const int sc = pc < 1536 ? pc : pc + 16;
            float acc[16];
#pragma unroll
            for (int r = 0; r < 16; ++r) acc[r] = 0.f;
            const float* wp = F.win + (size_t)(128 * wave) * PW + sc;
#pragma unroll 4
            for (int k = 0; k < 128; ++k) {
                const float wv = wp[(size_t)k * PW]; const LAS f32x4* xp = (const LAS f32x4*)(xm + (128 * wave + k) * 16);
#pragma unroll
                for (int q = 0; q < 4; ++q) { const f32x4 x4 = xp[q];
#pragma unroll
                    for (int i = 0; i < 4; ++i) acc[4 * q + i] += x4[i] * wv; }
            }
#pragma unroll
            for (int r = 0; r < 16; ++r) red[(wave * 16 + r) * 64 + lane] = acc[r];
        }
        __syncthreads();
#pragma unroll
        for (int i = 0; i < 2; ++i) {
            const int o = tid + 512 * i, r = o >> 6, l = o & 63; float s = 0.f;
#pragma unroll
            for (int w = 0; w < 8; ++w) s += red[(w * 16 + r) * 64 + l];
            const int j = F.bx * 64 + l; const int pc = j < 768 ? 256 + j : 2048 + (j - 768);
            F.PROJ[(size_t)(M + r) * NP + pc] = (bf16)f2bf(s);
        }
        __syncthreads();
    }
    {
        LAS float* scr = (LAS float*)(F.lds + wave * 16384);
        const int gw = F.bx * NWAVES + wave, NGW = F.G * NWAVES;
        constexpr int I_IN = 16 * 96, I_OUT = 16 * 32, I_UP = 16 * 128, I_DN = 64 * 32, NITEMS = I_IN + I_OUT + I_UP + I_DN;
        for (int it = gw; it < NITEMS; it += NGW) {
            int r = it;
            if (r < I_IN) { const int kb = r / 96, nb = r % 96, n0 = 32 * nb; p0_transpose_item(F.win, PW, D, F.WinT, n0, n0 < 1536 ? n0 : n0 + 16, 64 * kb, nullptr, n0 < 256 ? 0.125f : 1.0f, scr, lane); continue; } r -= I_IN;
            if (r < I_OUT) { const int kb = r / 32, nb = r % 32; p0_transpose_item(F.wout, D, D, F.WoutT, 32 * nb, 32 * nb, 64 * kb, nullptr, 1.0f, scr, lane); continue; } r -= I_OUT;
            if (r < I_UP) { const int kb = r / 128, nb = r % 128; p0_transpose_item(F.wup, FF, D, F.WupT, 32 * nb, 32 * nb, 64 * kb, F.nmlp, 1.0f, scr, lane); continue; } r -= I_UP;
            { const int kb = r / 32, nb = r % 32; p0_transpose_item(F.wdn, D, FF, F.WdnT, 32 * nb, 32 * nb, 64 * kb, nullptr, 1.0f, scr, lane); }
        }
    }
    __syncthreads();
    {
        LAS f32x4* T = (LAS f32x4*)F.lds;
#pragma unroll
        for (int i = 0; i < 8; ++i) { const int e = tid + 512 * i, ln = e & 63, c4 = (e >> 6) & 3, kg = e >> 8; const int k = 256 * (kg >> 2) + 4 * ln + (kg & 3);
            T[e] = *(const f32x4*)(F.win + (size_t)k * PW + SRC_GR + 4 * c4); }
        __syncthreads();
        const int gw = F.bx * NWAVES + wave, NGW = F.G * NWAVES;
        const f32x4* nw = (const f32x4*)F.nmix + lane;
        f32x4 nw4[4];
#pragma unroll
        for (int j = 0; j < 4; ++j) nw4[j] = nw[64 * j];
        for (int m = gw; m < MR; m += NGW) {
            asm volatile("" ::: "memory");
            const f32x4* xr = (const f32x4*)(m < M ? F.x + (size_t)m * D : F.meta + (size_t)(m - M) * D) + lane;
            f32x4 v[4]; float s = 0.f;
#pragma unroll
            for (int j = 0; j < 4; ++j) { v[j] = xr[64 * j]; s += (v[j][0] * v[j][0] + v[j][1] * v[j][1]) + (v[j][2] * v[j][2] + v[j][3] * v[j][3]); }
            const float rstd = 1.0f / sqrtf(wave_sum(s) * (1.0f / D) + EPS);
#pragma unroll
            for (int j = 0; j < 4; ++j) v[j] = v[j] * rstd * nw4[j];
            if (m < M) { unsigned long long* o8 = (unsigned long long*)(F.XN + (size_t)m * D) + lane;
#pragma unroll
                for (int j = 0; j < 4; ++j) o8[64 * j] = (unsigned long long)pk2(v[j][0], v[j][1]) | ((unsigned long long)pk2(v[j][2], v[j][3]) << 32); }
            float acc[16];
#pragma unroll
            for (int c = 0; c < 16; ++c) acc[c] = 0.f;
#pragma unroll
            for (int kg = 0; kg < 16; ++kg) { const float xv = v[kg >> 2][kg & 3];
#pragma unroll
                for (int c4 = 0; c4 < 4; ++c4) { const f32x4 w4 = T[(kg * 4 + c4) * 64 + lane];
#pragma unroll
                    for (int i = 0; i < 4; ++i) acc[4 * c4 + i] += xv * w4[i]; } }
            float r8[8], r4[4], r2[2], r1;
#pragma unroll
            for (int i = 0; i < 8; ++i) { const bool up = lane & 32; const float send = up ? acc[i] : acc[i + 8], keep = up ? acc[i + 8] : acc[i]; r8[i] = keep + __shfl_xor(send, 32); }
#pragma unroll
            for (int i = 0; i < 4; ++i) { const bool up = lane & 16; const float send = up ? r8[i] : r8[i + 4], keep = up ? r8[i + 4] : r8[i]; r4[i] = keep + __shfl_xor(send, 16); }
#pragma unroll
            for (int i = 0; i < 2; ++i) { const bool up = lane & 8; const float send = up ? r4[i] : r4[i + 2], keep = up ? r4[i + 2] : r4[i]; r2[i] = keep + __shfl_xor(send, 8); }
            { const bool up = lane & 4; const float send = up ? r2[0] : r2[1], keep = up ? r2[1] : r2[0]; r1 = keep + __shfl_xor(send, 4); }
            r1 += __shfl_xor(r1, 2); r1 += __shfl_xor(r1, 1);
            if ((lane & 3) == 0) F.GR[(size_t)m * 16 + (lane >> 2)] = r1;
        }
    }
    __syncthreads();
}

typedef short bf16x8 __attribute__((ext_vector_type(8)));
constexpr int GRS = 144;
constexpr int G_TOT = 0, G_EBL = 2048, G_RED = 2304, G_GR = 4352, G_QB = 8448, G_KB = 17664, G_KDT = 26880, G_AM = 36096, G_VT = 45312, G_HT = 63744, G_END = 82176;
static_assert(G_END <= MISC_OFF, "GLA LDS map");
__device__ __forceinline__ LAS unsigned char* opqb(LAS unsigned char* p) { asm volatile("" : "+v"(p)); return p; }
struct GlaRaw { unsigned q[8], k[8], v[16]; f32x4 gr; };
__device__ __forceinline__ float bfbits(unsigned u) { return __builtin_bit_cast(float, u << 16); }

template <bool FULL>
__device__ __forceinline__ void gla_load_raw(GlaRaw& R, const bf16* PROJ, const float* GR, int hh, bool meta, size_t m0, int tid) {
    const int d = tid & 63, tb = tid >> 6;
#pragma unroll
    for (int i = 0; i < 8; ++i) { const int t = 8 * tb + i; const bool ok = !meta || t >= 48; const size_t row = meta ? (size_t)(M + (ok ? t - 48 : 0)) : m0 + t;
        const bf16* p = PROJ + row * NP + hh * 64 + d; R.k[i] = ok ? (unsigned)p[C_K] : 0u; if (FULL) R.q[i] = ok ? (unsigned)p[C_Q] : 0u; else R.q[i] = 0u; }
    const int dvi = tid & 127, tq = tid >> 7;
#pragma unroll
    for (int i = 0; i < 16; ++i) { const int t = 16 * tq + i; const bool ok = !meta || t >= 48; const size_t row = meta ? (size_t)(M + (ok ? t - 48 : 0)) : m0 + t;
        R.v[i] = ok ? (unsigned)PROJ[row * NP + C_V + hh * 128 + dvi] : 0u; }
    R.gr = (f32x4){0.f, 0.f, 0.f, 0.f};
    if (tid < 256) { const int t = tid >> 2; const bool ok = !meta || t >= 48; const size_t row = meta ? (size_t)(M + (ok ? t - 48 : 0)) : m0 + t; R.gr = *(const f32x4*)(GR + row * 16 + 4 * (tid & 3)); }
}
template <bool FULL>
__device__ __forceinline__ void gla_stage_a(LAS unsigned char* lds, const GlaRaw& R, const float (&wgr)[16], float bg, bool meta, int tid, float& dprod) {
    const int d = tid & 63, tb = tid >> 6;
    if (tid < 256) *(LAS f32x4*)(lds + G_GR + tid * 16) = R.gr;
    { const int dvi = tid & 127, tq = tid >> 7; v4u lo, hi;
      lo.x = R.v[0] | (R.v[1] << 16); lo.y = R.v[2] | (R.v[3] << 16); lo.z = R.v[4] | (R.v[5] << 16); lo.w = R.v[6] | (R.v[7] << 16);
      hi.x = R.v[8] | (R.v[9] << 16); hi.y = R.v[10] | (R.v[11] << 16); hi.z = R.v[12] | (R.v[13] << 16); hi.w = R.v[14] | (R.v[15] << 16);
      *(LAS v4u*)(lds + G_VT + dvi * GRS + tq * 32) = lo; *(LAS v4u*)(lds + G_VT + dvi * GRS + tq * 32 + 16) = hi; }
    __syncthreads();
    float p[8];
#pragma unroll
    for (int i = 0; i < 8; ++i) { const int t = 8 * tb + i; const LAS f32x4* gp = (const LAS f32x4*)(lds + G_GR + t * 64); float z = bg;
#pragma unroll
        for (int q4 = 0; q4 < 4; ++q4) { const f32x4 g4 = gp[q4]; z += g4[0] * wgr[4 * q4] + g4[1] * wgr[4 * q4 + 1] + g4[2] * wgr[4 * q4 + 2] + g4[3] * wgr[4 * q4 + 3]; }
        const float ls = fminf(z, 0.f) - __logf(1.0f + __expf(-fabsf(z)));
        const float gk = (!meta || t >= 48) ? ls * (1.0f / 16.0f) : 0.f; p[i] = i ? p[i - 1] + gk : gk; }
    *(LAS float*)(lds + G_TOT + (tb * 64 + d) * 4) = p[7];
    __syncthreads();
    float off = 0.f, bl = 0.f;
#pragma unroll
    for (int j = 0; j < 8; ++j) { const float tv = *(const LAS float*)(lds + G_TOT + (j * 64 + d) * 4); bl += tv; off += (j < tb) ? tv : 0.f; }
    float kd[8];
#pragma unroll
    for (int i = 0; i < 8; ++i) { const int t = 8 * tb + i; const float bi = off + p[i], kf = bfbits(R.k[i]); kd[i] = kf * __expf(bl - bi);
        if (FULL) { const float qf = bfbits(R.q[i]);
            *(LAS unsigned short*)(lds + G_QB + t * GRS + 2 * d) = (unsigned short)f2bf(qf * __expf(bi));
            *(LAS unsigned short*)(lds + G_KB + t * GRS + 2 * d) = (unsigned short)f2bf(kf * __expf(-bi)); } }
    { v4u w; w.x = pk2(kd[0], kd[1]); w.y = pk2(kd[2], kd[3]); w.z = pk2(kd[4], kd[5]); w.w = pk2(kd[6], kd[7]); *(LAS v4u*)(lds + G_KDT + d * GRS + tb * 16) = w; }
    if (tb == 0) { const float e = __expf(bl); *(LAS float*)(lds + G_EBL + d * 4) = e; dprod *= e; }
    __syncthreads();
}
__device__ __forceinline__ void gla_state_mma(LAS unsigned char* lds, const bf16x8 (&va)[2], pg8::f32x4 (&hacc)[4], int r16, int kq) {
#pragma unroll
    for (int nb = 0; nb < 4; ++nb) { const float e = *(const LAS float*)(lds + G_EBL + (16 * nb + r16) * 4); hacc[nb] = hacc[nb] * e;
#pragma unroll
        for (int kk = 0; kk < 2; ++kk) { const bf16x8 bfr = *(const LAS bf16x8*)(lds + G_KDT + (16 * nb + r16) * GRS + kk * 64 + kq * 16);
            hacc[nb] = __builtin_amdgcn_mfma_f32_16x16x32_bf16(va[kk], bfr, hacc[nb], 0, 0, 0); } }
}
__device__ __forceinline__ void gla_load_va(LAS unsigned char* lds, bf16x8 (&va)[2], int w, int r16, int kq) {
#pragma unroll
    for (int kk = 0; kk < 2; ++kk) va[kk] = *(const LAS bf16x8*)(lds + G_VT + (16 * w + r16) * GRS + kk * 64 + kq * 16);
}
__device__ __forceinline__ void gla_write_ht(LAS unsigned char* hTw, const pg8::f32x4 (&hacc)[4], int r16, int kq) {
#pragma unroll
    for (int nb = 0; nb < 4; ++nb)
#pragma unroll
        for (int ii = 0; ii < 4; ++ii) *(LAS unsigned short*)(hTw + (4 * kq + ii) * GRS + (16 * nb + r16) * 2) = (unsigned short)f2bf(hacc[nb][ii]);
}
__device__ __forceinline__ void gla_state_chunk(LAS unsigned char* lds, const Frame& F, int hh, bool meta, size_t m0, const float (&wgr)[16], float bg, pg8::f32x4 (&hacc)[4], float& dprod) {
    const int tid = F.tid, w = tid >> 6, r16 = tid & 15, kq = (tid >> 4) & 3;
    GlaRaw R; gla_load_raw<false>(R, F.PROJ, F.GR, hh, meta, m0, tid);
    gla_stage_a<false>(lds, R, wgr, bg, meta, tid, dprod);
    bf16x8 va[2]; gla_load_va(lds, va, w, r16, kq);
    gla_state_mma(lds, va, hacc, r16, kq);
    __syncthreads();
}
__device__ __forceinline__ void gla_load_gate(const Frame& F, int hh, float (&wgr)[16], float& bg) {
    const int d = F.tid & 63;
#pragma unroll
    for (int r = 0; r < 16; ++r) wgr[r] = F.wgu[r * 256 + hh * 64 + d];
    bg = F.bgate[hh * 64 + d];
}
__device__ __forceinline__ void p2a_phase(Frame& F) {
    LAS unsigned char* lds = F.lds;
    for (int u = F.bx; u < 256; u += F.G) {
        const int g = u & 7, hh = (u >> 3) & 3, b = u >> 5;
        if (g == 7) continue;
        float wgr[16], bg; gla_load_gate(F, hh, wgr, bg);
        pg8::f32x4 hacc[4]; float dprod = 1.f;
#pragma unroll
        for (int nb = 0; nb < 4; ++nb) hacc[nb] = (pg8::f32x4){0.f, 0.f, 0.f, 0.f};
        if (g == 0) gla_state_chunk(lds, F, hh, true, 0, wgr, bg, hacc, dprod);
        for (int cc = 0; cc < 4; ++cc) gla_state_chunk(lds, F, hh, false, (size_t)b * SEQ + (size_t)(4 * g + cc) * 64, wgr, bg, hacc, dprod);
        f32x4* ap = (f32x4*)(F.AGG + ((size_t)u * NTHR + F.tid) * 16);
#pragma unroll
        for (int nb = 0; nb < 4; ++nb) ap[nb] = hacc[nb];
        if (F.tid < 64) F.DG[u * 64 + F.tid] = dprod;
    }
}
__device__ __forceinline__ void conv_loadu(const bf16* PROJ, size_t row, int ch, float (&u)[8]) {
    const v4u a = *(const v4u*)(PROJ + row * NP + C_CC + ch), b = *(const v4u*)(PROJ + row * NP + C_CX + ch);
    float fa[8], fb[8]; unpack8(a, fa); unpack8(b, fb);
#pragma unroll
    for (int i = 0; i < 8; ++i) u[i] = fa[i] * fb[i];
}
__device__ __forceinline__ void p2b_phase(Frame& F) {
    LAS unsigned char* lds = F.lds;
    const int tid = F.tid, w = tid >> 6, r16 = tid & 15, kq = (tid >> 4) & 3;
    for (int u = F.bx; u < 256; u += F.G) {
        const int g = u & 7, hh = (u >> 3) & 3, b = u >> 5;
        float wgr[16], bg; gla_load_gate(F, hh, wgr, bg);
        const f32x4 nw4 = *(const f32x4*)(F.gnw + 16 * w + 4 * kq);
        pg8::f32x4 hacc[4]; float dprod = 1.f;
        if (g == 0) {
#pragma unroll
            for (int nb = 0; nb < 4; ++nb) hacc[nb] = (pg8::f32x4){0.f, 0.f, 0.f, 0.f};
            gla_state_chunk(lds, F, hh, true, 0, wgr, bg, hacc, dprod);
        } else {
            const int u0 = u & ~7;
            { const f32x4* ap = (const f32x4*)(F.AGG + ((size_t)u0 * NTHR + tid) * 16);
#pragma unroll
                for (int nb = 0; nb < 4; ++nb) hacc[nb] = ap[nb]; }
            for (int gp = 1; gp < g; ++gp) {
                const f32x4* ap = (const f32x4*)(F.AGG + ((size_t)(u0 + gp) * NTHR + tid) * 16);
#pragma unroll
                for (int nb = 0; nb < 4; ++nb) { const float dg = F.DG[(size_t)(u0 + gp) * 64 + 16 * nb + r16]; hacc[nb] = hacc[nb] * dg + ap[nb]; }
            }
        }
        LAS unsigned char* hTw = opqb(lds + G_HT + 16 * w * GRS);
        gla_write_ht(hTw, hacc, r16, kq);
        for (int cc = 0; cc < 4; ++cc) {
            asm volatile("" ::: "memory");
            const size_t m0 = (size_t)b * SEQ + (size_t)(4 * g + cc) * 64;
            { GlaRaw R; gla_load_raw<true>(R, F.PROJ, F.GR, hh, false, m0, tid); gla_stage_a<true>(lds, R, wgr, bg, false, tid, dprod); }
            {
                const int jb = w & 3, ib0 = (w >> 2) * 2; bf16x8 a[2];
#pragma unroll
                for (int kk = 0; kk < 2; ++kk) a[kk] = *(const LAS bf16x8*)(lds + G_KB + (16 * jb + r16) * GRS + kk * 64 + kq * 16);
#pragma unroll
                for (int e = 0; e < 2; ++e) { const int ib = ib0 + e; pg8::f32x4 acc = (pg8::f32x4){0.f, 0.f, 0.f, 0.f};
#pragma unroll
                    for (int kk = 0; kk < 2; ++kk) { const bf16x8 bfr = *(const LAS bf16x8*)(lds + G_QB + (16 * ib + r16) * GRS + kk * 64 + kq * 16); acc = __builtin_amdgcn_mfma_f32_16x16x32_bf16(a[kk], bfr, acc, 0, 0, 0); }
                    const int i = 16 * ib + r16, j0 = 16 * jb + 4 * kq; v2u wv;
                    wv.x = pk2(j0 <= i ? acc[0] : 0.f, j0 + 1 <= i ? acc[1] : 0.f); wv.y = pk2(j0 + 2 <= i ? acc[2] : 0.f, j0 + 3 <= i ? acc[3] : 0.f);
                    *(LAS v2u*)(lds + G_AM + i * GRS + j0 * 2) = wv; }
            }
            v2u gq[4];
#pragma unroll
            for (int nb = 0; nb < 4; ++nb) gq[nb] = *(const v2u*)(F.PROJ + (m0 + 16 * nb + r16) * NP + C_G + hh * 128 + 16 * w + 4 * kq);
            __syncthreads();
            pg8::f32x4 o[4];
            {
                bf16x8 va[2], ha[2]; gla_load_va(lds, va, w, r16, kq);
#pragma unroll
                for (int kk = 0; kk < 2; ++kk) ha[kk] = *(const LAS bf16x8*)(hTw + r16 * GRS + kk * 64 + kq * 16);
#pragma unroll
                for (int nb = 0; nb < 4; ++nb) { pg8::f32x4 acc = (pg8::f32x4){0.f, 0.f, 0.f, 0.f};
#pragma unroll
                    for (int kk = 0; kk < 2; ++kk) { const bf16x8 bfr = *(const LAS bf16x8*)(lds + G_AM + (16 * nb + r16) * GRS + kk * 64 + kq * 16); acc = __builtin_amdgcn_mfma_f32_16x16x32_bf16(va[kk], bfr, acc, 0, 0, 0); }
#pragma unroll
                    for (int kk = 0; kk < 2; ++kk) { const bf16x8 bfr = *(const LAS bf16x8*)(lds + G_QB + (16 * nb + r16) * GRS + kk * 64 + kq * 16); acc = __builtin_amdgcn_mfma_f32_16x16x32_bf16(ha[kk], bfr, acc, 0, 0, 0); }
                    o[nb] = acc; }
                gla_state_mma(lds, va, hacc, r16, kq);
                gla_write_ht(hTw, hacc, r16, kq);
            }
#pragma unroll
            for (int nb = 0; nb < 4; ++nb) { float s = (o[nb][0] * o[nb][0] + o[nb][1] * o[nb][1]) + (o[nb][2] * o[nb][2] + o[nb][3] * o[nb][3]); s += __shfl_xor(s, 16); s += __shfl_xor(s, 32);
                if (kq == 0) *(LAS float*)(lds + G_RED + (w * 64 + 16 * nb + r16) * 4) = s; }
            __syncthreads();
#pragma unroll
            for (int nb = 0; nb < 4; ++nb) { float s = 0.f;
#pragma unroll
                for (int ww = 0; ww < 8; ++ww) s += *(const LAS float*)(lds + G_RED + (ww * 64 + 16 * nb + r16) * 4);
                const float rstd = 1.0f / sqrtf(s * (1.0f / 128.0f) + EPS);
                const float g0 = bflo(gq[nb].x), g1 = bfhi(gq[nb].x), g2 = bflo(gq[nb].y), g3 = bfhi(gq[nb].y);
                const float y0 = o[nb][0] * rstd * nw4[0] * (g0 / (1.0f + __expf(-g0))), y1 = o[nb][1] * rstd * nw4[1] * (g1 / (1.0f + __expf(-g1)));
                const float y2 = o[nb][2] * rstd * nw4[2] * (g2 / (1.0f + __expf(-g2))), y3 = o[nb][3] * rstd * nw4[3] * (g3 / (1.0f + __expf(-g3)));
                v2u wv; wv.x = pk2(y0, y1); wv.y = pk2(y2, y3);
                *(v2u*)(F.MIX + (m0 + 16 * nb + r16) * D + hh * 128 + 16 * w + 4 * kq) = wv; }
        }
        {
            const int cgp = tid & 63, rs = tid >> 6, ch = 8 * cgp; const size_t ms = (size_t)64 * u + rs * 8;
            float w0[8], w1[8], w2[8];
#pragma unroll
            for (int q = 0; q < 2; ++q) { const f32x4 a = *(const f32x4*)(F.convw + ch + 4 * q), bb = *(const f32x4*)(F.convw + 512 + ch + 4 * q), cc4 = *(const f32x4*)(F.convw + 1024 + ch + 4 * q);
#pragma unroll
                for (int e = 0; e < 4; ++e) { w0[4 * q + e] = a[e]; w1[4 * q + e] = bb[e]; w2[4 * q + e] = cc4[e]; } }
            const bool first = (ms % SEQ) == 0;
            float u2[8], u1[8], u0[8];
            conv_loadu(F.PROJ, first ? (size_t)(M + 14) : ms - 2, ch, u2);
            conv_loadu(F.PROJ, first ? (size_t)(M + 15) : ms - 1, ch, u1);
#pragma unroll 2
            for (int r = 0; r < 8; ++r) { const size_t row = ms + r; conv_loadu(F.PROJ, row, ch, u0);
                const v4u cb8 = *(const v4u*)(F.PROJ + row * NP + C_CB + ch); float cb[8], y[8]; unpack8(cb8, cb);
#pragma unroll
                for (int e = 0; e < 8; ++e) { y[e] = cb[e] * (w0[e] * u2[e] + w1[e] * u1[e] + w2[e] * u0[e]); u2[e] = u1[e]; u1[e] = u0[e]; }
                v4u wv; wv.x = pk2(y[0], y[1]); wv.y = pk2(y[2], y[3]); wv.z = pk2(y[4], y[5]); wv.w = pk2(y[6], y[7]);
                *(v4u*)(F.MIX + row * D + 512 + ch) = wv; }
        }
        __syncthreads();
    }
}

__global__ void __launch_bounds__(NTHR, 2) fwd(Args args) {
    extern __shared__ __attribute__((aligned(16))) unsigned char lds[];
    cg::grid_group grid = cg::this_grid();
    Frame F;
    F.lds = (LAS unsigned char*)lds; F.tid = threadIdx.x; F.lane = F.tid & 63; F.wave = __builtin_amdgcn_readfirstlane(F.tid >> 6); F.G = gridDim.x; F.bx = blockIdx.x;
    F.x = args.in[0]; F.meta = args.in[1]; F.nmix = args.in[2]; F.win = args.in[3]; F.wgu = args.in[4]; F.bgate = args.in[5]; F.gnw = args.in[6]; F.convw = args.in[7];
    F.wout = args.in[8]; F.nmlp = args.in[9]; F.wup = args.in[10]; F.wdn = args.in[11]; F.nfin = args.in[12]; F.out = args.out;
    unsigned char* ws = args.ws;
    F.WinT = (bf16*)(ws + WS_WIN); F.WoutT = (bf16*)(ws + WS_WOUT); F.WupT = (bf16*)(ws + WS_WUP); F.WdnT = (bf16*)(ws + WS_WDN);
    F.XN = (bf16*)(ws + WS_XN); F.PROJ = (bf16*)(ws + WS_PROJ); F.MIX = (bf16*)(ws + WS_MIX); F.HB = (bf16*)(ws + WS_HB);
    F.GR = (float*)(ws + WS_GR); F.AGG = (float*)(ws + WS_AGG); F.DG = (float*)(ws + WS_DG); F.SS1 = (float*)(ws + WS_SS1); F.SS2 = (float*)(ws + WS_SS2);
    const int lo = args.ph_lo, hi = args.ph_hi;
    if (F.tid < 16) ((volatile LAS unsigned*)(F.lds + MISC_OFF))[F.tid] = 0u;
    __syncthreads();
    XcdBarrier bar = xcd_barrier_post((unsigned*)(ws + WS_BAR), (volatile LAS unsigned*)(F.lds + MISC_OFF));
    if (hi == 99) grid.sync();
#define IN(k) (lo <= (k) && (k) < hi)
#define SEAM(k) do { if (IN(k) && IN((k) + 1)) xcd_barrier(bar); } while (0)
    if (IN(0) && !(SKIPMASK & 1)) { p0_prologue(F); if (REPMASK & 1) { xcd_barrier(bar); p0_prologue(F); } } SEAM(0);
    if (IN(1) && !(SKIPMASK & 2)) {
        pg8::Gemm g{F.XN, F.WinT, M, NP, D}; pg8::StaticOrder S; S.init(M, NP, F.G, F.bx);
        pg8::EpiBf16<0> E{F.PROJ, NP, nullptr, 0, 0, 1.0f};
        pg8::gemm_phase<pg8::EpiBf16<0>, pg8::StaticOrder, PG8_ALIGN, PG8_SP2>(F.lds, g, S, E);
    } SEAM(1);
    if (IN(2) && !(SKIPMASK & 4)) { p2a_phase(F); if (REPMASK & 4) { xcd_barrier(bar); p2a_phase(F); } } SEAM(2);
    if (IN(3) && !(SKIPMASK & 8)) { p2b_phase(F); if (REPMASK & 8) { xcd_barrier(bar); p2b_phase(F); } } SEAM(3);
    for (int es = 0; es < EXTRA_SYNCS; ++es) xcd_barrier(bar);
    if (IN(4) && !(SKIPMASK & 16)) {
        pg8::Gemm g{F.MIX, F.WoutT, M, D, D}; pg8::StaticOrder S; S.init(M, D, F.G, F.bx);
        EpiRes<true> E{F.x, F.out, F.XN, F.SS1};
        pg8::gemm_phase<EpiRes<true>, pg8::StaticOrder, false, PG8_SP2>(F.lds, g, S, E);
    } SEAM(4);
    if (IN(5) && !(SKIPMASK & 32)) {
        pg8::Gemm g{F.XN, F.WupT, M, FF, D}; pg8::StaticOrder S; S.init(M, FF, F.G, F.bx);
        EpiUp E{F.HB, FF, F.SS1};
        pg8::gemm_phase<EpiUp, pg8::StaticOrder, PG8_ALIGN, PG8_SP2>(F.lds, g, S, E);
    } SEAM(5);
    if (IN(6) && !(SKIPMASK & 64)) {
        pg8::Gemm g{F.HB, F.WdnT, M, D, FF}; pg8::StaticOrder S; S.init(M, D, F.G, F.bx);
        EpiRes<false> E{F.out, F.out, nullptr, F.SS2};
        pg8::gemm_phase<EpiRes<false>, pg8::StaticOrder, false, PG8_SP2>(F.lds, g, S, E);
    } SEAM(6);
    if (IN(7) && !(SKIPMASK & 128)) {
        const int gw = F.bx * NWAVES + F.wave, NGW = F.G * NWAVES; const f32x4* nw = (const f32x4*)F.nfin + F.lane;
        f32x4 nw4[4];
#pragma unroll
        for (int j = 0; j < 4; ++j) nw4[j] = nw[64 * j];
        for (int m = gw; m < M; m += NGW) {
            f32x4* xr = (f32x4*)(F.out + (size_t)m * D) + F.lane; const f32x4 s4 = *(const f32x4*)(F.SS2 + (size_t)m * 4);
            const float rstd = 1.0f / sqrtf(((s4[0] + s4[1]) + (s4[2] + s4[3])) * (1.0f / D) + EPS);
#pragma unroll
            for (int j = 0; j < 4; ++j) { const f32x4 v = xr[64 * j]; xr[64 * j] = v * rstd * nw4[j]; }
        }
    }
#undef IN
#undef SEAM
}

extern "C" void kernel_launch(void* const* d_in, const int* in_sizes, int n_in, void* d_out, int out_size, void* d_ws, size_t ws_size, hipStream_t stream) {
    static int grid = 0;
    if (grid == 0) {
        if (n_in != 13 || out_size != M * D || ws_size < 200 * MiB) { fprintf(stderr, "kernel_launch: unexpected problem shape\n"); grid = -1; return; }
        if (hipFuncSetAttribute((const void*)fwd, hipFuncAttributeMaxDynamicSharedMemorySize, LDS_BYTES) != hipSuccess) { fprintf(stderr, "kernel_launch: hipFuncSetAttribute failed\n"); grid = -1; return; }
        grid = 256;
    }
    if (grid < 0) return;
    Args a{};
    for (int i = 0; i < 13; ++i) a.in[i] = (const float*)d_in[i];
    a.out = (float*)d_out; a.ws = (unsigned char*)d_ws;
    if (hipMemsetAsync((char*)d_ws + WS_BAR, 0, BAR_BYTES, stream) != hipSuccess) { fprintf(stderr, "kernel_launch: memset of the barrier words failed\n"); return; }
#if ONE_LAUNCH
    a.ph_lo = 0; a.ph_hi = 8;
    void* kargs[] = {&a};
    hipError_t e = hipLaunchCooperativeKernel((void*)fwd, dim3(grid), dim3(NTHR), kargs, LDS_BYTES, stream);
    if (e != hipSuccess) fprintf(stderr, "cooperative launch failed: %s (grid %d)\n", hipGetErrorString(e), grid);
#else
    for (int p = 0; p < 8; ++p) { a.ph_lo = p; a.ph_hi = p + 1; hipLaunchKernelGGL(fwd, dim3(grid), dim3(NTHR), LDS_BYTES, stream, a); }
#endif
}
```

```cpp
#include <hip/hip_runtime.h>
#include <hip/hip_cooperative_groups.h>
#include <cstdio>
#include <cstdint>
#include <cmath>
namespace cg = cooperative_groups;
namespace pg8 {
#define PG8_LAS __attribute__((address_space(3)))
typedef unsigned short bf16_t;
typedef short bf16x8 __attribute__((ext_vector_type(8)));
typedef float f32x4 __attribute__((ext_vector_type(4)));
typedef unsigned u32x4 __attribute__((ext_vector_type(4)));
constexpr int BM = 256, BK = 64, HALF = 128, HTB = HALF * BK * 2  , STAGE_BYTES = 8 * HTB, NXCD = 8, WGM = 8;

__host__ __device__ __forceinline__ int lds_byte(int r, int c) { const int st = (r >> 4) * 2 + (c >> 5), rr = r & 15, cc = c & 31, ob = rr * 64 + cc * 2; return st * 1024 + (ob ^ (((ob >> 9) & 1) << 5)); }
__host__ __device__ __forceinline__ void stage_rc(int b, int& R, int& C) { const int st = b / 1024, sb = b % 1024, swz = sb ^ (((sb >> 9) & 1) << 5); R = (st >> 1) * 16 + swz / 64; C = (st & 1) * 32 + (swz % 64) / 2; }
__host__ __device__ __forceinline__ int perm32(int rho) { const int n = rho >> 4, i = rho & 15; return 8 * (i >> 2) + 4 * n + (i & 3); }

struct Unit { int pm, pn; };
struct Gemm { const bf16_t* A; const bf16_t* Bt; int M, N, K; };

struct StaticOrder {
    int nM, nN, nwg, G, c;
    __host__ __device__ void init(int M, int N, int G_, int c_) { nM = M / BM; nN = N / BM; nwg = nM * nN; G = G_; c = c_; }
    __host__ __device__ bool next(int i, Unit& u) const {
        const long L = (long)i * G + c; if (L >= nwg) return false;
        int wgid = (int)L; { const int q = nwg / NXCD, r = nwg % NXCD, xcd = wgid % NXCD, off = wgid / NXCD; wgid = (xcd < r ? xcd * (q + 1) : r * (q + 1) + (xcd - r) * q) + off; }
        const int nig = WGM * nN, gid = wgid / nig, fm = gid * WGM, gsz = (nM - fm) < WGM ? (nM - fm) : WGM;
        u.pm = fm + ((wgid % nig) % gsz); u.pn = (wgid % nig) / gsz; return true;
    }
    __device__ __forceinline__ void a_ready(const Unit&) const {}
    __device__ __forceinline__ void done(const Unit&) const {}
};

__device__ __forceinline__ unsigned cvt_pk_bf16(float lo, float hi) { unsigned r; asm volatile("v_cvt_pk_bf16_f32 %0, %1, %2" : "=v"(r) : "v"(lo), "v"(hi)); return r; }
typedef float f32x2 __attribute__((ext_vector_type(2)));
__device__ __forceinline__ f32x2 gelu_pk(f32x2 v) {
    const f32x2 av = __builtin_elementwise_abs(v), d = av * 0.2316418882f + 1.0f;
    f32x2 t; t.x = __builtin_amdgcn_rcpf(d.x); t.y = __builtin_amdgcn_rcpf(d.y);
    f32x2 q = t * 0.5307027145f + (-0.7265760135f); q = q * t + 0.7107068705f; q = q * t + (-0.142248368f); q = q * t + 0.127414796f; q = q * t;
    const f32x2 s = (v * v) * (-0.72134752044f);
    f32x2 e; e.x = __builtin_amdgcn_exp2f(s.x); e.y = __builtin_amdgcn_exp2f(s.y);
    const f32x2 m = v * (q * e), r = v - m;
    f32x2 o; o.x = v.x < 0.f ? m.x : r.x; o.y = v.y < 0.f ? m.y : r.y; return o;
}

template <int ACT  > struct EpiBf16 {
    static constexpr bool PERM = true, AFTER_DRAIN = false; static_assert(ACT == 0 || ACT == 1, "EpiBf16: ACT is 0 (none) or 1 (gelu_pk)");
    bf16_t* O; int ldc; const float* bias; int split_cols; size_t split_stride; float scale0;
    __device__ __forceinline__ void operator()(const f32x4 (&acc)[2][2][4][2], const Unit& u, int wr, int wc, int fr, int fq) const {
        const int row0 = u.pm * BM + wr * 64 + fr; int colt = u.pn * BM; bf16_t* base = O;
        float sc = 1.f; if (split_cols) { const int t = colt / split_cols; base += (size_t)t * split_stride; colt -= t * split_cols; if (t == 0) sc = scale0; }
        const int col0 = colt + wc * 32 + 8 * fq, bcol0 = u.pn * BM + wc * 32 + 8 * fq;
        f32x4 bv[2][2];
#pragma unroll
        for (int bj = 0; bj < 2; ++bj)
#pragma unroll
            for (int n = 0; n < 2; ++n) bv[bj][n] = bias ? *(const f32x4*)(bias + bcol0 + bj * HALF + 4 * n) : (f32x4){0.f, 0.f, 0.f, 0.f};
#pragma unroll
        for (int ai = 0; ai < 2; ++ai)
#pragma unroll
            for (int m = 0; m < 4; ++m) { bf16_t* rowp = base + (size_t)(row0 + ai * HALF + m * 16) * ldc + col0;
#pragma unroll
                for (int bj = 0; bj < 2; ++bj) { f32x4 v0 = acc[ai][bj][m][0] + bv[bj][0], v1 = acc[ai][bj][m][1] + bv[bj][1];
                    if (ACT == 1) { f32x2 a = gelu_pk((f32x2){v0[0], v0[1]}), b = gelu_pk((f32x2){v0[2], v0[3]}), c = gelu_pk((f32x2){v1[0], v1[1]}), d = gelu_pk((f32x2){v1[2], v1[3]});
                        v0 = (f32x4){a.x, a.y, b.x, b.y}; v1 = (f32x4){c.x, c.y, d.x, d.y}; }
                    v0 = v0 * sc; v1 = v1 * sc; u32x4 w; w.x = cvt_pk_bf16(v0[0], v0[1]); w.y = cvt_pk_bf16(v0[2], v0[3]); w.z = cvt_pk_bf16(v1[0], v1[1]); w.w = cvt_pk_bf16(v1[2], v1[3]);
                    *(u32x4*)(rowp + bj * HALF) = w; } }
    }
};

template <class Epi, class Sched, bool ALIGN_EPI = false, bool SP2 = false>
__device__ __forceinline__ void gemm_phase(PG8_LAS unsigned char* lds, const Gemm g, const Sched& S, const Epi& E) {
    const int tid = threadIdx.x, wid = __builtin_amdgcn_readfirstlane(tid >> 6), lane = tid & 63, wr = wid >> 2, wc = wid & 3, fr = lane & 15, fq = lane >> 4;
    const int K = g.K, nt = K / BK;
    unsigned voffA[2], voffB[2];
#pragma unroll
    for (int i = 0; i < 2; ++i) { int R, C; stage_rc(tid * 16 + i * 8192, R, C); const int Rb = Epi::PERM ? ((R & ~31) + perm32(R & 31)) : R;
        voffA[i] = (unsigned)(R * K + C) * 2u; voffB[i] = (unsigned)(Rb * K + C) * 2u; }
    const size_t kstep = (size_t)(BK * 2);
    const size_t hstep = (size_t)HALF * K * 2;
    const size_t tstep = 2 * hstep;
    const unsigned ldsw = (unsigned)wid * 1024u;
    const int aoff = lds_byte(wr * 64 + fr, fq * 8), boff = lds_byte(wc * 32 + fr, fq * 8);
#define PG8_SA(b, h) (((b) * 2 + (h)) * HTB)
#define PG8_SB(b, h) ((4 + (b) * 2 + (h)) * HTB)
#define PG8_STAGE(bufoff, gbase, voff) do { _Pragma("unroll") for (int _i = 0; _i < 2; ++_i) \
        __builtin_amdgcn_global_load_lds((const unsigned*)((const char*)(gbase) + (voff)[_i]), (PG8_LAS unsigned*)(lds + (bufoff) + ldsw + _i * 8192), 16, 0, 0); } while (0)
#define PG8_LDA(dst, b, h) do { _Pragma("unroll") for (int m = 0; m < 4; ++m) _Pragma("unroll") for (int k = 0; k < 2; ++k) dst[m][k] = *(const PG8_LAS bf16x8*)(lds + PG8_SA(b, h) + aoff + m * 2048 + k * 1024); } while (0)
#define PG8_LDB(dst, b, h) do { _Pragma("unroll") for (int n = 0; n < 2; ++n) _Pragma("unroll") for (int k = 0; k < 2; ++k) dst[n][k] = *(const PG8_LAS bf16x8*)(lds + PG8_SB(b, h) + boff + n * 2048 + k * 1024); } while (0)
#define PG8_MMA(ai, bj, At, Bt) do { __builtin_amdgcn_s_setprio(1); _Pragma("unroll") for (int m = 0; m < 4; ++m) _Pragma("unroll") for (int n = 0; n < 2; ++n) _Pragma("unroll") for (int k = 0; k < 2; ++k) \
        acc[ai][bj][m][n] = __builtin_amdgcn_mfma_f32_16x16x32_bf16(Bt[n][k], At[m][k], acc[ai][bj][m][n], 0, 0, 0); __builtin_amdgcn_s_setprio(0); } while (0)
#define PG8_WAIT_V(n) asm volatile("s_waitcnt vmcnt(" #n ")" ::: "memory")
#define PG8_WAIT_L(n) asm volatile("s_waitcnt lgkmcnt(" #n ")" ::: "memory")
#define PG8_BAR __builtin_amdgcn_s_barrier()
#define PG8_SCHED __builtin_amdgcn_sched_barrier(0)
    Unit cur, nxt; int ui = 0;
    if (!S.next(0, cur)) return;
    f32x4 acc[2][2][4][2];
#pragma unroll
    for (int a = 0; a < 2; ++a)
#pragma unroll
        for (int b = 0; b < 2; ++b)
#pragma unroll
            for (int m = 0; m < 4; ++m)
#pragma unroll
                for (int n = 0; n < 2; ++n) acc[a][b][m][n] = (f32x4){0.f, 0.f, 0.f, 0.f};
    bf16x8 At[4][2], B0[2][2], B1[2][2];
    const char* cA = (const char*)g.A + (size_t)cur.pm * tstep; const char* cB = (const char*)g.Bt + (size_t)cur.pn * tstep;
    S.a_ready(cur);
    if constexpr (SP2) {
        PG8_STAGE(PG8_SB(0, 0), cB, voffB); PG8_STAGE(PG8_SB(0, 1), cB + hstep, voffB); PG8_STAGE(PG8_SA(0, 0), cA, voffA); PG8_STAGE(PG8_SA(0, 1), cA + hstep, voffA);
        if (wr == 1) PG8_BAR;
        PG8_WAIT_V(2); PG8_BAR;
        PG8_STAGE(PG8_SB(1, 0), cB + kstep, voffB); PG8_STAGE(PG8_SA(1, 0), cA + kstep, voffA); PG8_STAGE(PG8_SB(1, 1), cB + hstep + kstep, voffB);
        PG8_WAIT_V(6); PG8_BAR;
    } else {
        PG8_STAGE(PG8_SB(0, 0), cB, voffB); PG8_STAGE(PG8_SA(0, 0), cA, voffA); PG8_STAGE(PG8_SB(0, 1), cB + hstep, voffB); PG8_STAGE(PG8_SA(0, 1), cA + hstep, voffA);
        if (wr == 1) PG8_BAR;
        PG8_WAIT_V(4); PG8_BAR;
        PG8_STAGE(PG8_SB(1, 0), cB + kstep, voffB); PG8_STAGE(PG8_SA(1, 0), cA + kstep, voffA); PG8_STAGE(PG8_SB(1, 1), cB + hstep + kstep, voffB);
        PG8_WAIT_V(6); PG8_BAR;
    }
    for (;;) {
        const bool has_next = S.next(ui + 1, nxt);
        const char* nA = has_next ? (const char*)g.A + (size_t)nxt.pm * tstep : cA; const char* nB = has_next ? (const char*)g.Bt + (size_t)nxt.pn * tstep : cB;
        for (int t = 0; t < nt; t += 2) {
            const bool last = (t == nt - 2);
            const char* a1 = cA + (size_t)(t + 1) * kstep;
            const char* a2 = last ? nA : cA + (size_t)(t + 2) * kstep; const char* b2 = last ? nB : cB + (size_t)(t + 2) * kstep;
            const char* a3 = a2 + kstep; const char* b3 = b2 + kstep;
            if (last && has_next) S.a_ready(nxt);
            if constexpr (SP2) {
            PG8_LDB(B0, 0, 0); PG8_LDB(B1, 0, 1); PG8_SCHED; PG8_LDA(At, 0, 0); PG8_STAGE(PG8_SA(1, 1), a1 + hstep, voffA);
            PG8_WAIT_V(8); PG8_WAIT_L(0); PG8_BAR; PG8_MMA(0, 0, At, B0); PG8_MMA(0, 1, At, B1); PG8_BAR; PG8_SCHED;
            PG8_LDA(At, 0, 1); PG8_STAGE(PG8_SB(0, 0), b2, voffB); PG8_STAGE(PG8_SB(0, 1), b2 + hstep, voffB); PG8_STAGE(PG8_SA(0, 0), a2, voffA);
            PG8_WAIT_V(8); PG8_WAIT_L(0); PG8_BAR; PG8_MMA(1, 0, At, B0); PG8_MMA(1, 1, At, B1); PG8_BAR; PG8_SCHED;
            PG8_LDB(B0, 1, 0); PG8_LDB(B1, 1, 1); PG8_SCHED; PG8_LDA(At, 1, 0); PG8_STAGE(PG8_SA(0, 1), a2 + hstep, voffA);
            PG8_WAIT_V(8); PG8_WAIT_L(0); PG8_BAR; PG8_MMA(0, 0, At, B0); PG8_MMA(0, 1, At, B1); PG8_BAR; PG8_SCHED;
            PG8_LDA(At, 1, 1); PG8_STAGE(PG8_SB(1, 0), b3, voffB); PG8_STAGE(PG8_SB(1, 1), b3 + hstep, voffB); PG8_STAGE(PG8_SA(1, 0), a3, voffA);
            PG8_WAIT_V(8); PG8_WAIT_L(0); PG8_BAR; PG8_MMA(1, 0, At, B0); PG8_MMA(1, 1, At, B1); PG8_BAR; PG8_SCHED;
            } else {
            PG8_LDB(B0, 0, 0); PG8_SCHED; PG8_LDA(At, 0, 0); PG8_STAGE(PG8_SA(1, 1), a1 + hstep, voffA);
            PG8_WAIT_L(8); PG8_BAR; PG8_WAIT_L(0); PG8_MMA(0, 0, At, B0); PG8_BAR; PG8_SCHED;
            PG8_LDB(B1, 0, 1); PG8_STAGE(PG8_SB(0, 0), b2, voffB);
            PG8_BAR; PG8_WAIT_L(0); PG8_MMA(0, 1, At, B1); PG8_BAR;
            PG8_LDA(At, 0, 1); PG8_STAGE(PG8_SA(0, 0), a2, voffA);
            PG8_BAR; PG8_WAIT_L(0); PG8_MMA(1, 0, At, B0); PG8_BAR; PG8_SCHED;
            PG8_STAGE(PG8_SB(0, 1), b2 + hstep, voffB);
            PG8_WAIT_V(6); PG8_BAR; PG8_MMA(1, 1, At, B1); PG8_BAR;
            PG8_LDB(B0, 1, 0); PG8_SCHED; PG8_LDA(At, 1, 0); PG8_STAGE(PG8_SA(0, 1), a2 + hstep, voffA);
            PG8_WAIT_L(8); PG8_BAR; PG8_WAIT_L(0); PG8_MMA(0, 0, At, B0); PG8_BAR; PG8_SCHED;
            PG8_LDB(B1, 1, 1); PG8_STAGE(PG8_SB(1, 0), b3, voffB);
            PG8_BAR; PG8_WAIT_L(0); PG8_MMA(0, 1, At, B1); PG8_BAR;
            PG8_LDA(At, 1, 1); PG8_STAGE(PG8_SA(1, 0), a3, voffA);
            PG8_BAR; PG8_WAIT_L(0); PG8_MMA(1, 0, At, B0); PG8_BAR; PG8_SCHED;
            PG8_STAGE(PG8_SB(1, 1), b3 + hstep, voffB);
            PG8_WAIT_V(6); PG8_BAR; PG8_MMA(1, 1, At, B1); PG8_BAR;
            }
        }
        if constexpr (ALIGN_EPI) { if (wr == 0) PG8_BAR; }
        if constexpr (!Epi::AFTER_DRAIN) { E(acc, cur, wr, wc, fr, fq); S.done(cur); }
        if (!has_next) break;
#pragma unroll
        for (int a = 0; a < 2; ++a)
#pragma unroll
            for (int b = 0; b < 2; ++b)
#pragma unroll
                for (int m = 0; m < 4; ++m)
#pragma unroll
                    for (int n = 0; n < 2; ++n) acc[a][b][m][n] = (f32x4){0.f, 0.f, 0.f, 0.f};
        cur = nxt; cA = nA; cB = nB; ++ui;
        if constexpr (ALIGN_EPI) { if (wr == 1) PG8_BAR; }
    }
    PG8_WAIT_V(0);
    if constexpr (!ALIGN_EPI) { if (wr == 0) PG8_BAR; }
    PG8_BAR;
    if constexpr (Epi::AFTER_DRAIN) { E.fused(acc, cur, wr, wc, fr, fq, lds, wid, lane); S.done(cur); }
#undef PG8_SA
#undef PG8_SB
#undef PG8_STAGE
#undef PG8_LDA
#undef PG8_LDB
#undef PG8_MMA
#undef PG8_WAIT_V
#undef PG8_WAIT_L
#undef PG8_BAR
#undef PG8_SCHED
}
}

#ifndef PG8_SP2
#define PG8_SP2 true
#endif
#ifndef PG8_ALIGN
#define PG8_ALIGN true
#endif
#ifndef SKIPMASK
#define SKIPMASK 0
#endif
#ifndef REPMASK
#define REPMASK 0
#endif
#ifndef EXTRA_SYNCS
#define EXTRA_SYNCS 0
#endif
#ifndef ONE_LAUNCH
#define ONE_LAUNCH 1
#endif
constexpr int NB = 8, SEQ = 2048, D = 1024, FF = 4096, M = NB * SEQ;
constexpr int NMETA = 16, MR = M + NMETA;
constexpr int PW = 3088, NP = 3072;
constexpr int C_Q = 0, C_K = 256, C_V = 512, C_G = 1024, C_CB = 1536, C_CC = 2048, C_CX = 2560;
constexpr int SRC_GR = 1536;
constexpr float EPS = 1e-6f;
constexpr size_t MiB = 1u << 20;
constexpr size_t WS_SS1 = 0, WS_SS2 = 256 * 1024;
constexpr size_t WS_WIN = 1 * MiB, WS_WOUT = 7 * MiB, WS_WUP = 9 * MiB, WS_WDN = 17 * MiB;
constexpr size_t WS_GR = 25 * MiB;
constexpr size_t WS_AGG = 27 * MiB, WS_DG = 35 * MiB;
constexpr size_t WS_XNM = 35 * MiB + 65536;
constexpr size_t WS_XN = 36 * MiB;
constexpr size_t WS_PROJ = 68 * MiB;
constexpr size_t WS_MIX = 166 * MiB;
constexpr size_t WS_HB = 68 * MiB;
constexpr size_t WS_BAR = 512 * 1024, BAR_BYTES = 16384;
constexpr int LDS_BYTES = 147456, MISC_OFF = LDS_BYTES - 64;
constexpr int NWAVES = 8, NTHR = 512;

#define LAS __attribute__((address_space(3)))
typedef unsigned short bf16;
typedef unsigned v4u __attribute__((ext_vector_type(4)));
typedef unsigned v2u __attribute__((ext_vector_type(2)));
typedef float f32x4 __attribute__((ext_vector_type(4)));
#define LDS_WAIT() asm volatile("s_waitcnt lgkmcnt(0)" ::: "memory")
__device__ __forceinline__ unsigned f2bf(float f) { unsigned u = __builtin_bit_cast(unsigned, f); return (u + 0x7fffu + ((u >> 16) & 1u)) >> 16; }
__device__ __forceinline__ unsigned pk2(float lo, float hi) { return f2bf(lo) | (f2bf(hi) << 16); }
__device__ __forceinline__ float bflo(unsigned u) { return __builtin_bit_cast(float, u << 16); }
__device__ __forceinline__ float bfhi(unsigned u) { return __builtin_bit_cast(float, u & 0xffff0000u); }
__device__ __forceinline__ void unpack8(v4u p, float (&o)[8]) { o[0] = bflo(p.x); o[1] = bfhi(p.x); o[2] = bflo(p.y); o[3] = bfhi(p.y); o[4] = bflo(p.z); o[5] = bfhi(p.z); o[6] = bflo(p.w); o[7] = bfhi(p.w); }
__device__ __forceinline__ float wave_sum(float v) {
#pragma unroll
    for (int o = 1; o < 64; o <<= 1) v += __shfl_xor(v, o);
    return v;
}

template <bool WB> struct EpiRes {
    static constexpr bool PERM = false, AFTER_DRAIN = true;
    const float* base; float* out; pg8::bf16_t* hb; float* ss;
    __device__ __forceinline__ void fused(pg8::f32x4 (&acc)[2][2][4][2], const pg8::Unit& u, int wr, int wc, int fr, int fq, LAS unsigned char* lds, int wid, int lane) const {
        LAS float* P = (LAS float*)lds;
        const int col0 = u.pn * 256 + wc * 32 + 4 * fq;
#pragma unroll
        for (int ai = 0; ai < 2; ++ai)
#pragma unroll
            for (int m = 0; m < 4; ++m) {
                const int r = ai * 128 + wr * 64 + m * 16 + fr; const size_t off = (size_t)(u.pm * 256 + r) * D + col0; float s = 0.f;
#pragma unroll
                for (int bj = 0; bj < 2; ++bj)
#pragma unroll
                    for (int n = 0; n < 2; ++n) {
                        f32x4 bs; if (WB) bs = *(const f32x4*)(base + off + bj * 128 + n * 16); else { const v2u hb2 = *(const v2u*)(hb + off + bj * 128 + n * 16); bs = (f32x4){bflo(hb2.x), bfhi(hb2.x), bflo(hb2.y), bfhi(hb2.y)}; }
                        const f32x4 v = acc[ai][bj][m][n] + bs;
                        if (!WB) *(f32x4*)(out + off + bj * 128 + n * 16) = v;
                        s += (v[0] * v[0] + v[1] * v[1]) + (v[2] * v[2] + v[3] * v[3]);
                        if (WB) { v2u w; w.x = pk2(v[0], v[1]); w.y = pk2(v[2], v[3]); *(v2u*)(hb + off + bj * 128 + n * 16) = w; }
                    }
                s += __shfl_xor(s, 16); s += __shfl_xor(s, 32);
                if (fq == 0) P[r * 4 + wc] = s;
                if (m & 1) asm volatile("" ::: "memory");
            }
        __syncthreads();
        const int tid = wid * 64 + lane;
        if (tid < 256) { const f32x4 p = *(const LAS f32x4*)(P + tid * 4); ss[(size_t)(u.pm * 256 + tid) * 4 + u.pn] = (p[0] + p[1]) + (p[2] + p[3]); }
    }
};
struct EpiUp {
    static constexpr bool PERM = true, AFTER_DRAIN = false;
    pg8::bf16_t* O; int ldc; const float* ss;
    __device__ __forceinline__ void operator()(const pg8::f32x4 (&acc)[2][2][4][2], const pg8::Unit& u, int wr, int wc, int fr, int fq) const {
        const int row0 = u.pm * 256 + wr * 64 + fr, col0 = u.pn * 256 + wc * 32 + 8 * fq;
#pragma unroll
        for (int ai = 0; ai < 2; ++ai)
#pragma unroll
            for (int m = 0; m < 4; ++m) {
                const int row = row0 + ai * 128 + m * 16; const f32x4 s4 = *(const f32x4*)(ss + (size_t)row * 4);
                const float rstd = __builtin_amdgcn_rsqf(((s4[0] + s4[1]) + (s4[2] + s4[3])) * (1.0f / D) + EPS);
                pg8::bf16_t* rowp = O + (size_t)row * ldc + col0;
#pragma unroll
                for (int bj = 0; bj < 2; ++bj) {
                    f32x4 v0 = acc[ai][bj][m][0] * rstd, v1 = acc[ai][bj][m][1] * rstd;
#pragma unroll
                    for (int e = 0; e < 4; ++e) { const float a = fmaxf(v0[e], 0.f), b = fmaxf(v1[e], 0.f); v0[e] = a * a; v1[e] = b * b; }
                    v4u w; w.x = pg8::cvt_pk_bf16(v0[0], v0[1]); w.y = pg8::cvt_pk_bf16(v0[2], v0[3]); w.z = pg8::cvt_pk_bf16(v1[0], v1[1]); w.w = pg8::cvt_pk_bf16(v1[2], v1[3]);
                    *(v4u*)(rowp + bj * 128) = w;
                }
            }
    }
};

#define RLX_AGENT __ATOMIC_RELAXED, __HIP_MEMORY_SCOPE_AGENT
#define XB_TMO      128
#define XB_XCNT(j)  (256  + 64 * (j))
#define XB_XSUB(j)  (1280 + 64 * (j))
#define XB_XGEN(j)  (2304 + 64 * (j))
#define XB_TOP      3328
#define XB_TOPGEN   3392
#define XCD_BAR_WORDS 3456
#define XB_SPIN_CAP (1u << 18)

__device__ __forceinline__ unsigned xb_ld(unsigned* p)              { return __hip_atomic_load(p, __ATOMIC_RELAXED, __HIP_MEMORY_SCOPE_AGENT); }
__device__ __forceinline__ unsigned xb_add(unsigned* p, unsigned v) { return __hip_atomic_fetch_add(p, v, __ATOMIC_RELAXED, __HIP_MEMORY_SCOPE_AGENT); }
__device__ __forceinline__ unsigned xb_xcc_id() { return (unsigned)__builtin_amdgcn_s_getreg((3 << 11) | 20) & 0xFu; }
#define XB_SPIN(cond, bar) do { unsigned _sp = 0; while (cond) { __builtin_amdgcn_s_sleep(1); \
    if ((++_sp & 255u) == 0u) { if (xb_ld(&(bar)[XB_TMO])) break; if (_sp > XB_SPIN_CAP) { atomicAdd(&(bar)[XB_TMO], 1u); break; } } } } while (0)

struct XcdBarrier {
    unsigned* bar; unsigned x;
    volatile LAS unsigned* st;
};

__device__ __forceinline__ XcdBarrier xcd_barrier_post(unsigned* bar, volatile LAS unsigned* st) {
    XcdBarrier b; b.bar = bar; b.x = xb_xcc_id(); b.st = st;
    if (threadIdx.x == 0) (void)xb_add(&bar[XB_XCNT(b.x)], 1u);
    return b;
}
__device__ __forceinline__ void xcd_barrier_complete(unsigned* bar, unsigned x, unsigned& nloc, unsigned& nx) {
    const unsigned G = gridDim.x * gridDim.y * gridDim.z;
    unsigned sum, cnt, mine, sp = 0u;
    for (;;) {
        sum = 0u; cnt = 0u; mine = 0u;
#pragma unroll
        for (unsigned j = 0; j < 16; ++j) { const unsigned c = xb_ld(&bar[XB_XCNT(j)]); sum += c; cnt += (c > 0u) ? 1u : 0u; mine = (j == x) ? c : mine; }
        if (sum == G) break;
        __builtin_amdgcn_s_sleep(1);
        if ((++sp & 255u) == 0u) { if (xb_ld(&bar[XB_TMO])) break; if (sp > XB_SPIN_CAP) { atomicAdd(&bar[XB_TMO], 1u); break; } }
    }
    nloc = mine > 0u ? mine : 1u; nx = cnt > 0u ? cnt : 1u;
}

__device__ __forceinline__ void xcd_barrier(const XcdBarrier& b) {
    asm volatile("s_waitcnt vmcnt(0)" ::: "memory");
    __syncthreads();
    if (threadIdx.x == 0) {
        unsigned* bar = b.bar;
        __builtin_amdgcn_s_waitcnt(0);
        unsigned nloc = b.st[0], nx = b.st[1];
        if (nloc == 0u) { xcd_barrier_complete(bar, b.x, nloc, nx); b.st[0] = nloc; b.st[1] = nx; }
        const unsigned old = xb_add(&bar[XB_XSUB(b.x)], 1u);
        const unsigned gen = old / nloc;
        if (old + 1u == (gen + 1u) * nloc) {
            __builtin_amdgcn_fence(__ATOMIC_RELEASE, "agent");
            asm volatile("s_waitcnt vmcnt(0)" ::: "memory");
            const unsigned og = xb_add(&bar[XB_TOP], 1u);
            const unsigned tg = og / nx;
            if (og + 1u == (tg + 1u) * nx) xb_add(&bar[XB_TOPGEN], 1u);
            else XB_SPIN(xb_ld(&bar[XB_TOPGEN]) == tg, bar);
            __builtin_amdgcn_fence(__ATOMIC_ACQUIRE, "agent");
            xb_add(&bar[XB_XGEN(b.x)], 1u);
            asm volatile("s_waitcnt vmcnt(0)" ::: "memory");
        } else {
            XB_SPIN(xb_ld(&bar[XB_XGEN(b.x)]) == gen, bar);
            __builtin_amdgcn_fence(__ATOMIC_ACQUIRE, "agent");
            asm volatile("s_waitcnt vmcnt(0)" ::: "memory");
        }
    }
    __syncthreads();
}

struct Args { const float* in[13]; float* out; unsigned char* ws; int ph_lo, ph_hi; };
struct Frame {
    LAS unsigned char* lds; int tid, lane, wave, G, bx;
    const float *x, *meta, *nmix, *win, *wgu, *bgate, *gnw, *convw, *wout, *nmlp, *wup, *wdn, *nfin; float* out;
    bf16 *WinT, *WoutT, *WupT, *WdnT, *XN, *XNM, *PROJ, *MIX, *HB; float *GR, *AGG, *DG, *SS1, *SS2;
};

__device__ __forceinline__ void p0_transpose_item(const float* W, int ldw, int K, bf16* WT, int n0, int sc0, int k0, const float* kscale, float cscale, LAS float* scr, int lane) {
#pragma unroll 8
    for (int i = 0; i < 32; ++i) { const int kk = 2 * i + (lane >> 5); float s = cscale; if (kscale) s *= kscale[k0 + kk]; scr[kk * 33 + (lane & 31)] = W[(size_t)(k0 + kk) * ldw + sc0 + (lane & 31)] * s; }
    LDS_WAIT(); asm volatile("" ::: "memory");
    const int c = lane & 7;
#pragma unroll
    for (int j = 0; j < 4; ++j) { const int n = (lane >> 3) + 8 * j; const LAS float* s = scr + (8 * c) * 33 + n;
        v4u o; o.x = pk2(s[0 * 33], s[1 * 33]); o.y = pk2(s[2 * 33], s[3 * 33]); o.z = pk2(s[4 * 33], s[5 * 33]); o.w = pk2(s[6 * 33], s[7 * 33]);
        *(v4u*)(WT + (size_t)(n0 + n) * K + k0 + 8 * c) = o; }
    LDS_WAIT(); asm volatile("" ::: "memory");
}
__device__ __forceinline__ void p0_prologue(Frame& F) {
    const int tid = F.tid, lane = F.lane, wave = F.wave;
    {
        LAS float* scr = (LAS float*)(F.lds + wave * 16384);
        const int gw = F.bx * NWAVES + wave, NGW = F.G * NWAVES;
        constexpr int I_IN = 16 * 96, I_OUT = 16 * 32, I_UP = 16 * 128, I_DN = 64 * 32, NITEMS = I_IN + I_OUT + I_UP + I_DN;
        for (int it = gw; it < NITEMS; it += NGW) {
            int r = it;
            if (r < I_IN) { const int kb = r / 96, nb = r % 96, n0 = 32 * nb; p0_transpose_item(F.win, PW, D, F.WinT, n0, n0 < 1536 ? n0 : n0 + 16, 64 * kb, nullptr, n0 < 256 ? 0.125f : 1.0f, scr, lane); continue; } r -= I_IN;
            if (r < I_OUT) { const int kb = r / 32, nb = r % 32; p0_transpose_item(F.wout, D, D, F.WoutT, 32 * nb, 32 * nb, 64 * kb, nullptr, 1.0f, scr, lane); continue; } r -= I_OUT;
            if (r < I_UP) { const int kb = r / 128, nb = r % 128; p0_transpose_item(F.wup, FF, D, F.WupT, 32 * nb, 32 * nb, 64 * kb, F.nmlp, 1.0f, scr, lane); continue; } r -= I_UP;
            { const int kb = r / 32, nb = r % 32; p0_transpose_item(F.wdn, D, FF, F.WdnT, 32 * nb, 32 * nb, 64 * kb, nullptr, 1.0f, scr, lane); }
        }
    }
    __syncthreads();
    {
        LAS f32x4* T = (LAS f32x4*)F.lds;
#pragma unroll
        for (int i = 0; i < 8; ++i) { const int e = tid + 512 * i, ln = e & 63, c4 = (e >> 6) & 3, kg = e >> 8; const int k = 256 * (kg >> 2) + 4 * ln + (kg & 3);
            T[e] = *(const f32x4*)(F.win + (size_t)k * PW + SRC_GR + 4 * c4); }
        __syncthreads();
        const int gw = F.bx * NWAVES + wave, NGW = F.G * NWAVES;
        const f32x4* nw = (const f32x4*)F.nmix + lane;
        f32x4 nw4[4];
#pragma unroll
        for (int j = 0; j < 4; ++j) nw4[j] = nw[64 * j];
        for (int m = gw; m < MR; m += NGW) {
            asm volatile("" ::: "memory");
            const f32x4* xr = (const f32x4*)(m < M ? F.x + (size_t)m * D : F.meta + (size_t)(m - M) * D) + lane;
            f32x4 v[4]; float s = 0.f;
#pragma unroll
            for (int j = 0; j < 4; ++j) { v[j] = xr[64 * j]; s += (v[j][0] * v[j][0] + v[j][1] * v[j][1]) + (v[j][2] * v[j][2] + v[j][3] * v[j][3]); }
            const float rstd = 1.0f / sqrtf(wave_sum(s) * (1.0f / D) + EPS);
#pragma unroll
            for (int j = 0; j < 4; ++j) v[j] = v[j] * rstd * nw4[j];
            { unsigned long long* o8 = (unsigned long long*)(m < M ? F.XN + (size_t)m * D : F.XNM + (size_t)(m - M) * D) + lane;
#pragma unroll
                for (int j = 0; j < 4; ++j) o8[64 * j] = (unsigned long long)pk2(v[j][0], v[j][1]) | ((unsigned long long)pk2(v[j][2], v[j][3]) << 32); }
            float acc[16];
#pragma unroll
            for (int c = 0; c < 16; ++c) acc[c] = 0.f;
#pragma unroll
            for (int kg = 0; kg < 16; ++kg) { const float xv = v[kg >> 2][kg & 3];
#pragma unroll
                for (int c4 = 0; c4 < 4; ++c4) { const f32x4 w4 = T[(kg * 4 + c4) * 64 + lane];
#pragma unroll
                    for (int i = 0; i < 4; ++i) acc[4 * c4 + i] += xv * w4[i]; } }
            float r8[8], r4[4], r2[2], r1;
#pragma unroll
            for (int i = 0; i < 8; ++i) { const bool up = lane & 32; const float send = up ? acc[i] : acc[i + 8], keep = up ? acc[i + 8] : acc[i]; r8[i] = keep + __shfl_xor(send, 32); }
#pragma unroll
            for (int i = 0; i < 4; ++i) { const bool up = lane & 16; const float send = up ? r8[i] : r8[i + 4], keep = up ? r8[i + 4] : r8[i]; r4[i] = keep + __shfl_xor(send, 16); }
#pragma unroll
            for (int i = 0; i < 2; ++i) { const bool up = lane & 8; const float send = up ? r4[i] : r4[i + 2], keep = up ? r4[i + 2] : r4[i]; r2[i] = keep + __shfl_xor(send, 8); }
            { const bool up = lane & 4; const float send = up ? r2[0] : r2[1], keep = up ? r2[1] : r2[0]; r1 = keep + __shfl_xor(send, 4); }
            r1 += __shfl_xor(r1, 2); r1 += __shfl_xor(r1, 1);
            if ((lane & 3) == 0) F.GR[(size_t)m * 16 + (lane >> 2)] = r1;
        }
    }
    __syncthreads();
}


typedef short bf16x8m __attribute__((ext_vector_type(8)));
__device__ __forceinline__ void p1_meta_proj(Frame& F) {
    if (F.bx < 56) {
        const int w = F.wave, lane = F.lane, r16 = lane & 15, kq = lane >> 4, cb = 2 * F.bx + (w >> 2), ks = w & 3;
        const int j = 16 * cb + r16, pc = j < 768 ? 256 + j : 2048 + (j - 768);
        const bf16* ap = F.XNM + (size_t)r16 * D + ks * 256 + 8 * kq; const bf16* bp = F.WinT + (size_t)pc * D + ks * 256 + 8 * kq;
        bf16x8m af[8], bfr[8];
#pragma unroll
        for (int kk = 0; kk < 8; ++kk) { af[kk] = *(const bf16x8m*)(ap + 32 * kk); bfr[kk] = *(const bf16x8m*)(bp + 32 * kk); }
        pg8::f32x4 acc = (pg8::f32x4){0.f, 0.f, 0.f, 0.f};
#pragma unroll
        for (int kk = 0; kk < 8; ++kk) acc = __builtin_amdgcn_mfma_f32_16x16x32_bf16(af[kk], bfr[kk], acc, 0, 0, 0);
        LAS f32x4* red = (LAS f32x4*)F.lds;
        red[w * 64 + lane] = acc;
        __syncthreads();
        if (ks == 0) { f32x4 s = red[w * 64 + lane];
#pragma unroll
            for (int q = 1; q < 4; ++q) { const f32x4 t = red[(w + q) * 64 + lane]; s = s + t; }
#pragma unroll
            for (int ii = 0; ii < 4; ++ii) F.PROJ[(size_t)(M + 4 * kq + ii) * NP + pc] = (bf16)f2bf(s[ii]); }
        __syncthreads();
    }
}
typedef short bf16x8 __attribute__((ext_vector_type(8)));
constexpr int GRS = 144;
constexpr int G_TOT = 0, G_EBL = 2048, G_RED = 2304, G_GR = 4352, G_QB = 8448, G_KB = 17664, G_KDT = 26880, G_AM = 36096, G_VT = 45312, G_HT = 63744, G_END = 82176;
static_assert(G_END <= MISC_OFF, "GLA LDS map");
__device__ __forceinline__ LAS unsigned char* opqb(LAS unsigned char* p) { asm volatile("" : "+v"(p)); return p; }
struct GlaRaw { unsigned q[8], k[8], v[16]; f32x4 gr; };
__device__ __forceinline__ float bfbits(unsigned u) { return __builtin_bit_cast(float, u << 16); }

template <bool FULL>
__device__ __forceinline__ void gla_load_raw(GlaRaw& R, const bf16* PROJ, const float* GR, int hh, bool meta, size_t m0, int tid) {
    const int d = tid & 63, tb = tid >> 6;
#pragma unroll
    for (int i = 0; i < 8; ++i) { const int t = 8 * tb + i; const bool ok = !meta || t >= 48; const size_t row = meta ? (size_t)(M + (ok ? t - 48 : 0)) : m0 + t;
        const bf16* p = PROJ + row * NP + hh * 64 + d; R.k[i] = ok ? (unsigned)p[C_K] : 0u; if (FULL) R.q[i] = ok ? (unsigned)p[C_Q] : 0u; else R.q[i] = 0u; }
    const int dvi = tid & 127, tq = tid >> 7;
#pragma unroll
    for (int i = 0; i < 16; ++i) { const int t = 16 * tq + i; const bool ok = !meta || t >= 48; const size_t row = meta ? (size_t)(M + (ok ? t - 48 : 0)) : m0 + t;
        R.v[i] = ok ? (unsigned)PROJ[row * NP + C_V + hh * 128 + dvi] : 0u; }
    R.gr = (f32x4){0.f, 0.f, 0.f, 0.f};
    if (tid < 256) { const int t = tid >> 2; const bool ok = !meta || t >= 48; const size_t row = meta ? (size_t)(M + (ok ? t - 48 : 0)) : m0 + t; R.gr = *(const f32x4*)(GR + row * 16 + 4 * (tid & 3)); }
}
template <bool FULL>
__device__ __forceinline__ void gla_stage_a(LAS unsigned char* lds, const GlaRaw& R, const float (&wgr)[16], float bg, bool meta, int tid, float& dprod) {
    const int d = tid & 63, tb = tid >> 6;
    if (tid < 256) *(LAS f32x4*)(lds + G_GR + tid * 16) = R.gr;
    { const int dvi = tid & 127, tq = tid >> 7; v4u lo, hi;
      lo.x = R.v[0] | (R.v[1] << 16); lo.y = R.v[2] | (R.v[3] << 16); lo.z = R.v[4] | (R.v[5] << 16); lo.w = R.v[6] | (R.v[7] << 16);
      hi.x = R.v[8] | (R.v[9] << 16); hi.y = R.v[10] | (R.v[11] << 16); hi.z = R.v[12] | (R.v[13] << 16); hi.w = R.v[14] | (R.v[15] << 16);
      *(LAS v4u*)(lds + G_VT + dvi * GRS + tq * 32) = lo; *(LAS v4u*)(lds + G_VT + dvi * GRS + tq * 32 + 16) = hi; }
    __syncthreads();
    float p[8];
#pragma unroll
    for (int i = 0; i < 8; ++i) { const int t = 8 * tb + i; const LAS f32x4* gp = (const LAS f32x4*)(lds + G_GR + t * 64); float z = bg;
#pragma unroll
        for (int q4 = 0; q4 < 4; ++q4) { const f32x4 g4 = gp[q4]; z += g4[0] * wgr[4 * q4] + g4[1] * wgr[4 * q4 + 1] + g4[2] * wgr[4 * q4 + 2] + g4[3] * wgr[4 * q4 + 3]; }
        const float ls = fminf(z, 0.f) - __logf(1.0f + __expf(-fabsf(z)));
        const float gk = (!meta || t >= 48) ? ls * (1.0f / 16.0f) : 0.f; p[i] = i ? p[i - 1] + gk : gk; }
    *(LAS float*)(lds + G_TOT + (tb * 64 + d) * 4) = p[7];
    __syncthreads();
    float off = 0.f, bl = 0.f;
#pragma unroll
    for (int j = 0; j < 8; ++j) { const float tv = *(const LAS float*)(lds + G_TOT + (j * 64 + d) * 4); bl += tv; off += (j < tb) ? tv : 0.f; }
    float kd[8];
#pragma unroll
    for (int i = 0; i < 8; ++i) { const int t = 8 * tb + i; const float bi = off + p[i], kf = bfbits(R.k[i]); kd[i] = kf * __expf(bl - bi);
        if (FULL) { const float qf = bfbits(R.q[i]);
            *(LAS unsigned short*)(lds + G_QB + t * GRS + 2 * d) = (unsigned short)f2bf(qf * __expf(bi));
            *(LAS unsigned short*)(lds + G_KB + t * GRS + 2 * d) = (unsigned short)f2bf(kf * __expf(-bi)); } }
    { v4u w; w.x = pk2(kd[0], kd[1]); w.y = pk2(kd[2], kd[3]); w.z = pk2(kd[4], kd[5]); w.w = pk2(kd[6], kd[7]); *(LAS v4u*)(lds + G_KDT + d * GRS + tb * 16) = w; }
    if (tb == 0) { const float e = __expf(bl); *(LAS float*)(lds + G_EBL + d * 4) = e; dprod *= e; }
    __syncthreads();
}
__device__ __forceinline__ void gla_state_mma(LAS unsigned char* lds, const bf16x8 (&va)[2], pg8::f32x4 (&hacc)[4], int r16, int kq) {
#pragma unroll
    for (int nb = 0; nb < 4; ++nb) { const float e = *(const LAS float*)(lds + G_EBL + (16 * nb + r16) * 4); hacc[nb] = hacc[nb] * e;
#pragma unroll
        for (int kk = 0; kk < 2; ++kk) { const bf16x8 bfr = *(const LAS bf16x8*)(lds + G_KDT + (16 * nb + r16) * GRS + kk * 64 + kq * 16);
            hacc[nb] = __builtin_amdgcn_mfma_f32_16x16x32_bf16(va[kk], bfr, hacc[nb], 0, 0, 0); } }
}
__device__ __forceinline__ void gla_load_va(LAS unsigned char* lds, bf16x8 (&va)[2], int w, int r16, int kq) {
#pragma unroll
    for (int kk = 0; kk < 2; ++kk) va[kk] = *(const LAS bf16x8*)(lds + G_VT + (16 * w + r16) * GRS + kk * 64 + kq * 16);
}
__device__ __forceinline__ void gla_write_ht(LAS unsigned char* hTw, const pg8::f32x4 (&hacc)[4], int r16, int kq) {
#pragma unroll
    for (int nb = 0; nb < 4; ++nb)
#pragma unroll
        for (int ii = 0; ii < 4; ++ii) *(LAS unsigned short*)(hTw + (4 * kq + ii) * GRS + (16 * nb + r16) * 2) = (unsigned short)f2bf(hacc[nb][ii]);
}
__device__ __forceinline__ void gla_state_chunk(LAS unsigned char* lds, const Frame& F, int hh, bool meta, size_t m0, const float (&wgr)[16], float bg, pg8::f32x4 (&hacc)[4], float& dprod) {
    const int tid = F.tid, w = tid >> 6, r16 = tid & 15, kq = (tid >> 4) & 3;
    GlaRaw R; gla_load_raw<false>(R, F.PROJ, F.GR, hh, meta, m0, tid);
    gla_stage_a<false>(lds, R, wgr, bg, meta, tid, dprod);
    bf16x8 va[2]; gla_load_va(lds, va, w, r16, kq);
    gla_state_mma(lds, va, hacc, r16, kq);
    __syncthreads();
}
__device__ __forceinline__ void gla_load_gate(const Frame& F, int hh, float (&wgr)[16], float& bg) {
    const int d = F.tid & 63;
#pragma unroll
    for (int r = 0; r < 16; ++r) wgr[r] = F.wgu[r * 256 + hh * 64 + d];
    bg = F.bgate[hh * 64 + d];
}
__device__ __forceinline__ void p2a_phase(Frame& F) {
    LAS unsigned char* lds = F.lds;
    for (int u = F.bx; u < 256; u += F.G) {
        const int g = u & 7, hh = (u >> 3) & 3, b = u >> 5;
        if (g == 7) continue;
        float wgr[16], bg; gla_load_gate(F, hh, wgr, bg);
        pg8::f32x4 hacc[4]; float dprod = 1.f;
#pragma unroll
        for (int nb = 0; nb < 4; ++nb) hacc[nb] = (pg8::f32x4){0.f, 0.f, 0.f, 0.f};
        if (g == 0) gla_state_chunk(lds, F, hh, true, 0, wgr, bg, hacc, dprod);
        for (int cc = 0; cc < 4; ++cc) gla_state_chunk(lds, F, hh, false, (size_t)b * SEQ + (size_t)(4 * g + cc) * 64, wgr, bg, hacc, dprod);
        f32x4* ap = (f32x4*)(F.AGG + ((size_t)u * NTHR + F.tid) * 16);
#pragma unroll
        for (int nb = 0; nb < 4; ++nb) ap[nb] = hacc[nb];
        if (F.tid < 64) F.DG[u * 64 + F.tid] = dprod;
    }
}
__device__ __forceinline__ void conv_loadu(const bf16* PROJ, size_t row, int ch, float (&u)[8]) {
    const v4u a = *(const v4u*)(PROJ + row * NP + C_CC + ch), b = *(const v4u*)(PROJ + row * NP + C_CX + ch);
    float fa[8], fb[8]; unpack8(a, fa); unpack8(b, fb);
#pragma unroll
    for (int i = 0; i < 8; ++i) u[i] = fa[i] * fb[i];
}
__device__ __forceinline__ void p2b_phase(Frame& F) {
    LAS unsigned char* lds = F.lds;
    const int tid = F.tid, w = tid >> 6, r16 = tid & 15, kq = (tid >> 4) & 3;
    for (int u = F.bx; u < 256; u += F.G) {
        const int g = u & 7, hh = (u >> 3) & 3, b = u >> 5;
        float wgr[16], bg; gla_load_gate(F, hh, wgr, bg);
        const f32x4 nw4 = *(const f32x4*)(F.gnw + 16 * w + 4 * kq);
        pg8::f32x4 hacc[4]; float dprod = 1.f;
        if (g == 0) {
#pragma unroll
            for (int nb = 0; nb < 4; ++nb) hacc[nb] = (pg8::f32x4){0.f, 0.f, 0.f, 0.f};
            gla_state_chunk(lds, F, hh, true, 0, wgr, bg, hacc, dprod);
        } else {
            const int u0 = u & ~7;
            { const f32x4* ap = (const f32x4*)(F.AGG + ((size_t)u0 * NTHR + tid) * 16);
#pragma unroll
                for (int nb = 0; nb < 4; ++nb) hacc[nb] = ap[nb]; }
            for (int gp = 1; gp < g; ++gp) {
                const f32x4* ap = (const f32x4*)(F.AGG + ((size_t)(u0 + gp) * NTHR + tid) * 16);
#pragma unroll
                for (int nb = 0; nb < 4; ++nb) { const float dg = F.DG[(size_t)(u0 + gp) * 64 + 16 * nb + r16]; hacc[nb] = hacc[nb] * dg + ap[nb]; }
            }
        }
        LAS unsigned char* hTw = opqb(lds + G_HT + 16 * w * GRS);
        gla_write_ht(hTw, hacc, r16, kq);
        for (int cc = 0; cc < 4; ++cc) {
            asm volatile("" ::: "memory");
            const size_t m0 = (size_t)b * SEQ + (size_t)(4 * g + cc) * 64;
            { GlaRaw R; gla_load_raw<true>(R, F.PROJ, F.GR, hh, false, m0, tid); gla_stage_a<true>(lds, R, wgr, bg, false, tid, dprod); }
            {
                const int jb = w & 3, ib0 = (w >> 2) * 2; bf16x8 a[2];
#pragma unroll
                for (int kk = 0; kk < 2; ++kk) a[kk] = *(const LAS bf16x8*)(lds + G_KB + (16 * jb + r16) * GRS + kk * 64 + kq * 16);
#pragma unroll
                for (int e = 0; e < 2; ++e) { const int ib = ib0 + e; pg8::f32x4 acc = (pg8::f32x4){0.f, 0.f, 0.f, 0.f};
#pragma unroll
                    for (int kk = 0; kk < 2; ++kk) { const bf16x8 bfr = *(const LAS bf16x8*)(lds + G_QB + (16 * ib + r16) * GRS + kk * 64 + kq * 16); acc = __builtin_amdgcn_mfma_f32_16x16x32_bf16(a[kk], bfr, acc, 0, 0, 0); }
                    const int i = 16 * ib + r16, j0 = 16 * jb + 4 * kq; v2u wv;
                    wv.x = pk2(j0 <= i ? acc[0] : 0.f, j0 + 1 <= i ? acc[1] : 0.f); wv.y = pk2(j0 + 2 <= i ? acc[2] : 0.f, j0 + 3 <= i ? acc[3] : 0.f);
                    *(LAS v2u*)(lds + G_AM + i * GRS + j0 * 2) = wv; }
            }
            v2u gq[4];
#pragma unroll
            for (int nb = 0; nb < 4; ++nb) gq[nb] = *(const v2u*)(F.PROJ + (m0 + 16 * nb + r16) * NP + C_G + hh * 128 + 16 * w + 4 * kq);
            __syncthreads();
            pg8::f32x4 o[4];
            {
                bf16x8 va[2], ha[2]; gla_load_va(lds, va, w, r16, kq);
#pragma unroll
                for (int kk = 0; kk < 2; ++kk) ha[kk] = *(const LAS bf16x8*)(hTw + r16 * GRS + kk * 64 + kq * 16);
#pragma unroll
                for (int nb = 0; nb < 4; ++nb) { pg8::f32x4 acc = (pg8::f32x4){0.f, 0.f, 0.f, 0.f};
#pragma unroll
                    for (int kk = 0; kk < 2; ++kk) { const bf16x8 bfr = *(const LAS bf16x8*)(lds + G_AM + (16 * nb + r16) * GRS + kk * 64 + kq * 16); acc = __builtin_amdgcn_mfma_f32_16x16x32_bf16(va[kk], bfr, acc, 0, 0, 0); }
#pragma unroll
                    for (int kk = 0; kk < 2; ++kk) { const bf16x8 bfr = *(const LAS bf16x8*)(lds + G_QB + (16 * nb + r16) * GRS + kk * 64 + kq * 16); acc = __builtin_amdgcn_mfma_f32_16x16x32_bf16(ha[kk], bfr, acc, 0, 0, 0); }
                    o[nb] = acc; }
                gla_state_mma(lds, va, hacc, r16, kq);
                gla_write_ht(hTw, hacc, r16, kq);
            }
#pragma unroll
            for (int nb = 0; nb < 4; ++nb) { float s = (o[nb][0] * o[nb][0] + o[nb][1] * o[nb][1]) + (o[nb][2] * o[nb][2] + o[nb][3] * o[nb][3]); s += __shfl_xor(s, 16); s += __shfl_xor(s, 32);
                if (kq == 0) *(LAS float*)(lds + G_RED + (w * 64 + 16 * nb + r16) * 4) = s; }
            __syncthreads();
#pragma unroll
            for (int nb = 0; nb < 4; ++nb) { float s = 0.f;
#pragma unroll
                for (int ww = 0; ww < 8; ++ww) s += *(const LAS float*)(lds + G_RED + (ww * 64 + 16 * nb + r16) * 4);
                const float rstd = 1.0f / sqrtf(s * (1.0f / 128.0f) + EPS);
                const float g0 = bflo(gq[nb].x), g1 = bfhi(gq[nb].x), g2 = bflo(gq[nb].y), g3 = bfhi(gq[nb].y);
                const float y0 = o[nb][0] * rstd * nw4[0] * (g0 / (1.0f + __expf(-g0))), y1 = o[nb][1] * rstd * nw4[1] * (g1 / (1.0f + __expf(-g1)));
                const float y2 = o[nb][2] * rstd * nw4[2] * (g2 / (1.0f + __expf(-g2))), y3 = o[nb][3] * rstd * nw4[3] * (g3 / (1.0f + __expf(-g3)));
                v2u wv; wv.x = pk2(y0, y1); wv.y = pk2(y2, y3);
                *(v2u*)(F.MIX + (m0 + 16 * nb + r16) * D + hh * 128 + 16 * w + 4 * kq) = wv; }
        }
        {
            const int cgp = tid & 63, rs = tid >> 6, ch = 8 * cgp; const size_t ms = (size_t)64 * u + rs * 8;
            float w0[8], w1[8], w2[8];
#pragma unroll
            for (int q = 0; q < 2; ++q) { const f32x4 a = *(const f32x4*)(F.convw + ch + 4 * q), bb = *(const f32x4*)(F.convw + 512 + ch + 4 * q), cc4 = *(const f32x4*)(F.convw + 1024 + ch + 4 * q);
#pragma unroll
                for (int e = 0; e < 4; ++e) { w0[4 * q + e] = a[e]; w1[4 * q + e] = bb[e]; w2[4 * q + e] = cc4[e]; } }
            const bool first = (ms % SEQ) == 0;
            float u2[8], u1[8], u0[8];
            conv_loadu(F.PROJ, first ? (size_t)(M + 14) : ms - 2, ch, u2);
            conv_loadu(F.PROJ, first ? (size_t)(M + 15) : ms - 1, ch, u1);
#pragma unroll 2
            for (int r = 0; r < 8; ++r) { const size_t row = ms + r; conv_loadu(F.PROJ, row, ch, u0);
                const v4u cb8 = *(const v4u*)(F.PROJ + row * NP + C_CB + ch); float cb[8], y[8]; unpack8(cb8, cb);
#pragma unroll
                for (int e = 0; e < 8; ++e) { y[e] = cb[e] * (w0[e] * u2[e] + w1[e] * u1[e] + w2[e] * u0[e]); u2[e] = u1[e]; u1[e] = u0[e]; }
                v4u wv; wv.x = pk2(y[0], y[1]); wv.y = pk2(y[2], y[3]); wv.z = pk2(y[4], y[5]); wv.w = pk2(y[6], y[7]);
                *(v4u*)(F.MIX + row * D + 512 + ch) = wv; }
        }
        __syncthreads();
    }
}

__global__ void __launch_bounds__(NTHR, 2) fwd(Args args) {
    extern __shared__ __attribute__((aligned(16))) unsigned char lds[];
    cg::grid_group grid = cg::this_grid();
    Frame F;
    F.lds = (LAS unsigned char*)lds; F.tid = threadIdx.x; F.lane = F.tid & 63; F.wave = __builtin_amdgcn_readfirstlane(F.tid >> 6); F.G = gridDim.x; F.bx = blockIdx.x;
    F.x = args.in[0]; F.meta = args.in[1]; F.nmix = args.in[2]; F.win = args.in[3]; F.wgu = args.in[4]; F.bgate = args.in[5]; F.gnw = args.in[6]; F.convw = args.in[7];
    F.wout = args.in[8]; F.nmlp = args.in[9]; F.wup = args.in[10]; F.wdn = args.in[11]; F.nfin = args.in[12]; F.out = args.out;
    unsigned char* ws = args.ws;
    F.WinT = (bf16*)(ws + WS_WIN); F.WoutT = (bf16*)(ws + WS_WOUT); F.WupT = (bf16*)(ws + WS_WUP); F.WdnT = (bf16*)(ws + WS_WDN);
    F.XN = (bf16*)(ws + WS_XN); F.XNM = (bf16*)(ws + WS_XNM); F.PROJ = (bf16*)(ws + WS_PROJ); F.MIX = (bf16*)(ws + WS_MIX); F.HB = (bf16*)(ws + WS_HB);
    F.GR = (float*)(ws + WS_GR); F.AGG = (float*)(ws + WS_AGG); F.DG = (float*)(ws + WS_DG); F.SS1 = (float*)(ws + WS_SS1); F.SS2 = (float*)(ws + WS_SS2);
    const int lo = args.ph_lo, hi = args.ph_hi;
    if (F.tid < 16) ((volatile LAS unsigned*)(F.lds + MISC_OFF))[F.tid] = 0u;
    __syncthreads();
    XcdBarrier bar = xcd_barrier_post((unsigned*)(ws + WS_BAR), (volatile LAS unsigned*)(F.lds + MISC_OFF));
    if (hi == 99) grid.sync();
#define IN(k) (lo <= (k) && (k) < hi)
#define SEAM(k) do { if (IN(k) && IN((k) + 1)) xcd_barrier(bar); } while (0)
    if (IN(0) && !(SKIPMASK & 1)) { p0_prologue(F); if (REPMASK & 1) { xcd_barrier(bar); p0_prologue(F); } } SEAM(0);
    if (IN(1) && !(SKIPMASK & 2)) {
        p1_meta_proj(F);
        pg8::Gemm g{F.XN, F.WinT, M, NP, D}; pg8::StaticOrder S; S.init(M, NP, F.G, F.bx);
        pg8::EpiBf16<0> E{F.PROJ, NP, nullptr, 0, 0, 1.0f};
        pg8::gemm_phase<pg8::EpiBf16<0>, pg8::StaticOrder, PG8_ALIGN, PG8_SP2>(F.lds, g, S, E);
    } SEAM(1);
    if (IN(2) && !(SKIPMASK & 4)) { p2a_phase(F); if (REPMASK & 4) { xcd_barrier(bar); p2a_phase(F); } } SEAM(2);
    if (IN(3) && !(SKIPMASK & 8)) { p2b_phase(F); if (REPMASK & 8) { xcd_barrier(bar); p2b_phase(F); } } SEAM(3);
    for (int es = 0; es < EXTRA_SYNCS; ++es) xcd_barrier(bar);
    if (IN(4) && !(SKIPMASK & 16)) {
        pg8::Gemm g{F.MIX, F.WoutT, M, D, D}; pg8::StaticOrder S; S.init(M, D, F.G, F.bx);
        EpiRes<true> E{F.x, F.out, F.XN, F.SS1};
        pg8::gemm_phase<EpiRes<true>, pg8::StaticOrder, false, PG8_SP2>(F.lds, g, S, E);
    } SEAM(4);
    if (IN(5) && !(SKIPMASK & 32)) {
        pg8::Gemm g{F.XN, F.WupT, M, FF, D}; pg8::StaticOrder S; S.init(M, FF, F.G, F.bx);
        EpiUp E{F.HB, FF, F.SS1};
        pg8::gemm_phase<EpiUp, pg8::StaticOrder, PG8_ALIGN, PG8_SP2>(F.lds, g, S, E);
    } SEAM(5);
    if (IN(6) && !(SKIPMASK & 64)) {
        pg8::Gemm g{F.HB, F.WdnT, M, D, FF}; pg8::StaticOrder S; S.init(M, D, F.G, F.bx);
        EpiRes<false> E{nullptr, F.out, F.XN, F.SS2};
        pg8::gemm_phase<EpiRes<false>, pg8::StaticOrder, false, PG8_SP2>(F.lds, g, S, E);
    } SEAM(6);
    if (IN(7) && !(SKIPMASK & 128)) {
        const int gw = F.bx * NWAVES + F.wave, NGW = F.G * NWAVES; const f32x4* nw = (const f32x4*)F.nfin + F.lane;
        f32x4 nw4[4];
#pragma unroll
        for (int j = 0; j < 4; ++j) nw4[j] = nw[64 * j];
        for (int m = gw; m < M; m += NGW) {
            f32x4* xr = (f32x4*)(F.out + (size_t)m * D) + F.lane; const f32x4 s4 = *(const f32x4*)(F.SS2 + (size_t)m * 4);
            const float rstd = 1.0f / sqrtf(((s4[0] + s4[1]) + (s4[2] + s4[3])) * (1.0f / D) + EPS);
#pragma unroll
            for (int j = 0; j < 4; ++j) { const f32x4 v = xr[64 * j]; xr[64 * j] = v * rstd * nw4[j]; }
        }
    }
#undef IN
#undef SEAM
}

extern "C" void kernel_launch(void* const* d_in, const int* in_sizes, int n_in, void* d_out, int out_size, void* d_ws, size_t ws_size, hipStream_t stream) {
    static int grid = 0;
    if (grid == 0) {
        if (n_in != 13 || out_size != M * D || ws_size < 200 * MiB) { fprintf(stderr, "kernel_launch: unexpected problem shape\n"); grid = -1; return; }
        if (hipFuncSetAttribute((const void*)fwd, hipFuncAttributeMaxDynamicSharedMemorySize, LDS_BYTES) != hipSuccess) { fprintf(stderr, "kernel_launch: hipFuncSetAttribute failed\n"); grid = -1; return; }
        grid = 256;
    }
    if (grid < 0) return;
    Args a{};
    for (int i = 0; i < 13; ++i) a.in[i] = (const float*)d_in[i];
    a.out = (float*)d_out; a.ws = (unsigned char*)d_ws;
    if (hipMemsetAsync((char*)d_ws + WS_BAR, 0, BAR_BYTES, stream) != hipSuccess) { fprintf(stderr, "kernel_launch: memset of the barrier words failed\n"); return; }
#if ONE_LAUNCH
    a.ph_lo = 0; a.ph_hi = 8;
    void* kargs[] = {&a};
    hipError_t e = hipLaunchCooperativeKernel((void*)fwd, dim3(grid), dim3(NTHR), kargs, LDS_BYTES, stream);
    if (e != hipSuccess) fprintf(stderr, "cooperative launch failed: %s (grid %d)\n", hipGetErrorString(e), grid);
#else
    for (int p = 0; p < 8; ++p) { a.ph_lo = p; a.ph_hi = p + 1; hipLaunchKernelGGL(fwd, dim3(grid), dim3(NTHR), LDS_BYTES, stream, a); }
#endif
}
```
